# Optimizing an MI355X kernel written in HIP

```python
import jax, jax.numpy as jnp
from jax import lax
import numpy as np

D_MODEL = 1024
BATCH = 16
SEQ = 4096
DEPTH = 4

N_META = 16
EPS = 1e-6
CONV_WIDTH = D_MODEL // 2
CONV_GROUPS = 8
SHORT_CONV_K = 3
LRU_WIDTH = D_MODEL // 2
LRU_HEADS = 8
LRU_HEAD_DIM = LRU_WIDTH // LRU_HEADS
LRU_CONV_K = 4
LRU_C = 8.0
EVEN_IN = 3 * CONV_WIDTH + 2 * LRU_WIDTH
EVEN_MIX = CONV_WIDTH + LRU_WIDTH
MLA_HEADS = 16
QK_NOPE = 64
QK_ROPE = 32
QK_HEAD = QK_NOPE + QK_ROPE
V_HEAD = 64
Q_LORA = 384
KV_LORA = 256
ODD_IN = Q_LORA + KV_LORA + QK_ROPE
ROPE_BASE = 10000.0
ATTN_BLOCK = 128
D_FF = 2816
FFN_CONV_K = 3
N_EVEN = (DEPTH + 1) // 2
N_ODD = DEPTH // 2

kernel_name = "hybrid_conv_rglru_mla_convffn"


def rms_norm(x, g):
    xf = x.astype(jnp.float32)
    y = xf * lax.rsqrt(jnp.mean(xf * xf, axis=-1, keepdims=True) + EPS)
    return (y * g.astype(jnp.float32)).astype(x.dtype)


def causal_dwconv(x, w):
    k_width = w.shape[0]
    t_len = x.shape[1]
    xp = jnp.pad(x, ((0, 0), (k_width - 1, 0), (0, 0)))
    y = xp[:, 0:t_len] * w[0]
    for k in range(1, k_width):
        y = y + xp[:, k:k + t_len] * w[k]
    return y


def rope_tables(t_len):
    pos = jnp.arange(t_len, dtype=jnp.float32)
    inv_freq = ROPE_BASE ** (-jnp.arange(0, QK_ROPE, 2, dtype=jnp.float32) / QK_ROPE)
    ang = pos[:, None] * inv_freq[None, :]
    return jnp.cos(ang), jnp.sin(ang)


def apply_rope(x, cos, sin):
    xf = x.astype(jnp.float32)
    x1, x2 = jnp.split(xf, 2, axis=-1)
    out = jnp.concatenate([x1 * cos - x2 * sin, x2 * cos + x1 * sin], axis=-1)
    return out.astype(x.dtype)


def rg_lru(xc, r_w, r_b, i_w, i_b, lam):
    b, t, _ = xc.shape
    xh = xc.reshape(b, t, LRU_HEADS, LRU_HEAD_DIM)
    r = jax.nn.sigmoid(jnp.einsum('bthi,hij->bthj', xh, r_w).reshape(b, t, LRU_WIDTH) + r_b)
    i = jax.nn.sigmoid(jnp.einsum('bthi,hij->bthj', xh, i_w).reshape(b, t, LRU_WIDTH) + i_b)
    log_a = -LRU_C * r.astype(jnp.float32) * jax.nn.softplus(-lam.astype(jnp.float32))
    a = jnp.exp(log_a)
    mult = jnp.sqrt(-jnp.expm1(2.0 * log_a))
    u = mult * (i * xc).astype(jnp.float32)

    def combine(left, right):
        a1, b1 = left
        a2, b2 = right
        return a1 * a2, a2 * b1 + b2

    _, h = lax.associative_scan(combine, (a, u), axis=1)
    return h.astype(xc.dtype)


def even_layer(x, norm, w_in, conv_a, conv_b, conv_b_bias, r_w, r_b, i_w, i_b, lam, w_out):
    h = rms_norm(x, norm)
    u = h @ w_in
    gb, gc, xa, xb, gate = jnp.split(
        u, [CONV_WIDTH, 2 * CONV_WIDTH, 3 * CONV_WIDTH, 3 * CONV_WIDTH + LRU_WIDTH], axis=-1)
    y_a = gb * causal_dwconv(gc * xa, conv_a)
    xc = causal_dwconv(xb, conv_b) + conv_b_bias
    y_b = jax.nn.gelu(gate) * rg_lru(xc, r_w, r_b, i_w, i_b, lam)
    return x + jnp.concatenate([y_a, y_b], axis=-1) @ w_out


def causal_block_attention(q, k, v):
    b, t, nh, dq = q.shape
    nb = -(-t // ATTN_BLOCK)
    tp = nb * ATTN_BLOCK
    pad = ((0, 0), (0, tp - t), (0, 0), (0, 0))
    q, k, v = jnp.pad(q, pad), jnp.pad(k, pad), jnp.pad(v, pad)
    qb = q.reshape(b, nb, ATTN_BLOCK, nh, dq).transpose(1, 0, 2, 3, 4)
    key_pos = jnp.arange(tp)
    scale = QK_HEAD ** -0.5
    neg = jnp.finfo(jnp.float32).min

    def one_block(args):
        q_blk, blk = args
        s = jnp.einsum('bqhd,bkhd->bhqk', q_blk, k).astype(jnp.float32) * scale
        q_pos = blk * ATTN_BLOCK + jnp.arange(ATTN_BLOCK)
        mask = key_pos[None, :] <= q_pos[:, None]
        s = jnp.where(mask[None, None], s, neg)
        p = jax.nn.softmax(s, axis=-1).astype(v.dtype)
        return jnp.einsum('bhqk,bkhd->bqhd', p, v)

    out = lax.map(one_block, (qb, jnp.arange(nb)))
    out = out.transpose(1, 0, 2, 3, 4).reshape(b, tp, nh, V_HEAD)
    return out[:, :t]


def odd_layer(x, cos, sin, norm, w_in, q_norm, kv_norm, w_uq, w_ukv, w_out):
    b, t, _ = x.shape
    h = rms_norm(x, norm)
    u = h @ w_in
    cq, ckv, k_r = jnp.split(u, [Q_LORA, Q_LORA + KV_LORA], axis=-1)
    q = (rms_norm(cq, q_norm) @ w_uq).reshape(b, t, MLA_HEADS, QK_HEAD)
    q_nope, q_rope = jnp.split(q, [QK_NOPE], axis=-1)
    q_rope = apply_rope(q_rope, cos[:, None, :], sin[:, None, :])
    kv = (rms_norm(ckv, kv_norm) @ w_ukv).reshape(b, t, MLA_HEADS, QK_NOPE + V_HEAD)
    k_nope, v = jnp.split(kv, [QK_NOPE], axis=-1)
    k_rope = apply_rope(k_r, cos, sin)
    k_rope = jnp.broadcast_to(k_rope[:, :, None, :], (b, t, MLA_HEADS, QK_ROPE))
    qf = jnp.concatenate([q_nope, q_rope], axis=-1)
    kf = jnp.concatenate([k_nope, k_rope], axis=-1)
    o = causal_block_attention(qf, kf, v).reshape(b, t, MLA_HEADS * V_HEAD)
    return x + o @ w_out


def ffn_layer(x, norm, w_up, conv_w, conv_b, w_down):
    h = rms_norm(x, norm)
    u = causal_dwconv(h @ w_up, conv_w) + conv_b
    a, g = jnp.split(u, 2, axis=-1)
    return x + (jax.nn.silu(a) * g) @ w_down


def setup_inputs(seed: int = 0) -> dict:
    key = jax.random.key(seed)
    ks = iter(jax.random.split(key, 40))

    def nrm(shape, scale):
        return jax.random.normal(next(ks), shape, jnp.float32) * scale

    def gain(shape):
        return 1.0 + nrm(shape, 0.01)

    u = jax.random.uniform(next(ks), (N_EVEN, LRU_WIDTH), jnp.float32, 0.9, 0.999)
    a_base = u ** (1.0 / LRU_C)
    lam = jnp.log(a_base) - jnp.log1p(-a_base)
    return {
        "x": nrm((BATCH, SEQ, D_MODEL), 1.0),
        "meta_tokens": nrm((N_META, D_MODEL), 1.0),
        "ev_norm": gain((N_EVEN, D_MODEL)),
        "ev_w_in": nrm((N_EVEN, D_MODEL, EVEN_IN), D_MODEL ** -0.5),
        "ev_conv_a": nrm((N_EVEN, SHORT_CONV_K, CONV_WIDTH), SHORT_CONV_K ** -0.5),
        "ev_conv_b": nrm((N_EVEN, LRU_CONV_K, LRU_WIDTH), LRU_CONV_K ** -0.5),
        "ev_conv_b_bias": nrm((N_EVEN, LRU_WIDTH), 0.02),
        "ev_gate_r_w": nrm((N_EVEN, LRU_HEADS, LRU_HEAD_DIM, LRU_HEAD_DIM), LRU_HEAD_DIM ** -0.5),
        "ev_gate_r_b": nrm((N_EVEN, LRU_WIDTH), 0.02),
        "ev_gate_i_w": nrm((N_EVEN, LRU_HEADS, LRU_HEAD_DIM, LRU_HEAD_DIM), LRU_HEAD_DIM ** -0.5),
        "ev_gate_i_b": nrm((N_EVEN, LRU_WIDTH), 0.02),
        "ev_lru_lambda": lam,
        "ev_w_out": nrm((N_EVEN, EVEN_MIX, D_MODEL), EVEN_MIX ** -0.5),
        "od_norm": gain((N_ODD, D_MODEL)),
        "od_w_in": nrm((N_ODD, D_MODEL, ODD_IN), D_MODEL ** -0.5),
        "od_q_norm": gain((N_ODD, Q_LORA)),
        "od_kv_norm": gain((N_ODD, KV_LORA)),
        "od_w_uq": nrm((N_ODD, Q_LORA, MLA_HEADS * QK_HEAD), Q_LORA ** -0.5),
        "od_w_ukv": nrm((N_ODD, KV_LORA, MLA_HEADS * (QK_NOPE + V_HEAD)), KV_LORA ** -0.5),
        "od_w_out": nrm((N_ODD, MLA_HEADS * V_HEAD, D_MODEL), (MLA_HEADS * V_HEAD) ** -0.5),
        "ffn_norm": gain((DEPTH, D_MODEL)),
        "ffn_w_up": nrm((DEPTH, D_MODEL, 2 * D_FF), D_MODEL ** -0.5),
        "ffn_conv_w": nrm((DEPTH, FFN_CONV_K, 2 * D_FF), FFN_CONV_K ** -0.5),
        "ffn_conv_b": nrm((DEPTH, 2 * D_FF), 0.02),
        "ffn_w_down": nrm((DEPTH, D_FF, D_MODEL), D_FF ** -0.5),
        "final_norm": gain((D_MODEL,)),
    }


def reference(x, meta_tokens, ev_norm, ev_w_in, ev_conv_a, ev_conv_b, ev_conv_b_bias,
              ev_gate_r_w, ev_gate_r_b, ev_gate_i_w, ev_gate_i_b, ev_lru_lambda, ev_w_out,
              od_norm, od_w_in, od_q_norm, od_kv_norm, od_w_uq, od_w_ukv, od_w_out,
              ffn_norm, ffn_w_up, ffn_conv_w, ffn_conv_b, ffn_w_down, final_norm):
    b = x.shape[0]
    meta = jnp.broadcast_to(meta_tokens[None].astype(x.dtype), (b, N_META, D_MODEL))
    h = jnp.concatenate([meta, x], axis=1)
    cos, sin = rope_tables(h.shape[1])
    for layer in range(DEPTH):
        j = layer // 2
        if layer % 2 == 0:
            h = even_layer(h, ev_norm[j], ev_w_in[j], ev_conv_a[j], ev_conv_b[j], ev_conv_b_bias[j],
                           ev_gate_r_w[j], ev_gate_r_b[j], ev_gate_i_w[j], ev_gate_i_b[j],
                           ev_lru_lambda[j], ev_w_out[j])
        else:
            h = odd_layer(h, cos, sin, od_norm[j], od_w_in[j], od_q_norm[j], od_kv_norm[j],
                          od_w_uq[j], od_w_ukv[j], od_w_out[j])
        h = ffn_layer(h, ffn_norm[layer], ffn_w_up[layer], ffn_conv_w[layer], ffn_conv_b[layer],
                      ffn_w_down[layer])
    h = rms_norm(h, final_norm)
    return h[:, N_META:]
```

```cpp
#include <hip/hip_runtime.h>
#include <hip/hip_cooperative_groups.h>
#include <cstdio>
#include <cstdint>
namespace cg = cooperative_groups;
namespace pg8 {
#define PG8_LAS __attribute__((address_space(3)))
typedef unsigned short bf16_t;
typedef short bf16x8 __attribute__((ext_vector_type(8)));
typedef float f32x4 __attribute__((ext_vector_type(4)));
typedef unsigned u32x4 __attribute__((ext_vector_type(4)));
constexpr int BM = 256, BK = 64, HALF = 128, HTB = HALF * BK * 2  , STAGE_BYTES = 8 * HTB, NXCD = 8, WGM = 8;

__host__ __device__ __forceinline__ int lds_byte(int r, int c) { const int st = (r >> 4) * 2 + (c >> 5), rr = r & 15, cc = c & 31, ob = rr * 64 + cc * 2; return st * 1024 + (ob ^ (((ob >> 9) & 1) << 5)); }
__host__ __device__ __forceinline__ void stage_rc(int b, int& R, int& C) { const int st = b / 1024, sb = b % 1024, swz = sb ^ (((sb >> 9) & 1) << 5); R = (st >> 1) * 16 + swz / 64; C = (st & 1) * 32 + (swz % 64) / 2; }
__host__ __device__ __forceinline__ int perm32(int rho) { const int n = rho >> 4, i = rho & 15; return 8 * (i >> 2) + 4 * n + (i & 3); }

struct Unit { int pm, pn; };
struct Gemm { const bf16_t* A; const bf16_t* Bt; int M, N, K; int lda, ldb; size_t atstep, btstep, a_pn, b_pm; };

struct StaticOrder {
    int nM, nN, nwg, G, c;
    __host__ __device__ void init(int M, int N, int G_, int c_) { nM = M / BM; nN = N / BM; nwg = nM * nN; G = G_; c = c_; }
    __host__ __device__ bool next(int i, Unit& u) const {
        const long L = (long)i * G + c; if (L >= nwg) return false;
        int wgid = (int)L; { const int q = nwg / NXCD, r = nwg % NXCD, xcd = wgid % NXCD, off = wgid / NXCD; wgid = (xcd < r ? xcd * (q + 1) : r * (q + 1) + (xcd - r) * q) + off; }
        const int nig = WGM * nN, gid = wgid / nig, fm = gid * WGM, gsz = (nM - fm) < WGM ? (nM - fm) : WGM;
        u.pm = fm + ((wgid % nig) % gsz); u.pn = (wgid % nig) / gsz; return true;
    }
    __device__ __forceinline__ void a_ready(const Unit&) const {}
    __device__ __forceinline__ void done(const Unit&) const {}
};

__device__ __forceinline__ unsigned cvt_pk_bf16(float lo, float hi) { unsigned r; asm volatile("v_cvt_pk_bf16_f32 %0, %1, %2" : "=v"(r) : "v"(lo), "v"(hi)); return r; }
#define GAS __attribute__((address_space(1)))
typedef unsigned u32x2 __attribute__((ext_vector_type(2)));
typedef float f32x2v __attribute__((ext_vector_type(2)));
typedef __bf16 bf16x2v __attribute__((ext_vector_type(2)));
__device__ __forceinline__ unsigned pk2(float lo, float hi) { f32x2v v = {lo, hi}; bf16x2v b = __builtin_convertvector(v, bf16x2v); return __builtin_bit_cast(unsigned, b); }
constexpr int TT = 4112;

__device__ __forceinline__ float row_rstd(const float* ss, int row, int fq) {
    const f32x4 a = *(GAS const f32x4*)(ss + (size_t)row * 16 + 4 * fq);
    float s = (a[0] + a[1]) + (a[2] + a[3]);
    s += __int_as_float(__builtin_amdgcn_ds_swizzle(__float_as_int(s), (16 << 10) | 0x1f));
    { auto rr = __builtin_amdgcn_permlane32_swap(__float_as_uint(s), __float_as_uint(s), false, false); s = __uint_as_float(rr[0]) + __uint_as_float(rr[1]); }
    return rsqrtf(s * (1.f / 1024) + 1e-6f);
}
template <int MODE> struct EpiStore {
    static constexpr bool PERM = true, AFTER_DRAIN = false;
    bf16_t* O; int ldc; bf16_t* O2; int ld2; int split; const float* ss;
    __device__ __forceinline__ void operator()(const f32x4 (&acc)[2][2][4][2], const Unit& u, int wr, int wc, int fr, int fq) const {
        const int row0 = u.pm * BM + wr * 64 + fr; const int ct = u.pn * BM;
        bf16_t* base = O; int ld = ldc; int c0 = ct + wc * 32 + 8 * fq;
        if (ct >= split) { base = O2; ld = ld2; c0 -= split; }
#pragma unroll
        for (int ai = 0; ai < 2; ++ai)
#pragma unroll
            for (int m = 0; m < 4; ++m) { const int row = row0 + ai * HALF + m * 16; bf16_t* rp = base + (size_t)row * ld;
                float rs = 1.f; if (MODE == 0 && ss) rs = row_rstd(ss, row, fq);
#pragma unroll
                for (int bj = 0; bj < 2; ++bj) { int c = c0 + bj * HALF;
                    if (MODE == 1) { const int b_ = row / TT, t_ = row - b_ * TT; rp = base; c = (((b_ * 16 + (c >> 6)) * TT + t_) * 96) + (c & 63); }
                    if (MODE == 2) { const int b_ = c / TT, t_ = c - b_ * TT; rp = base + ((size_t)((b_ * 16 + (row >> 6)) * 64 + (row & 63))) * 4160; c = t_; }
                    const f32x4 v0 = acc[ai][bj][m][0] * rs, v1 = acc[ai][bj][m][1] * rs; u32x4 w; w.x = pk2(v0[0], v0[1]); w.y = pk2(v0[2], v0[3]); w.z = pk2(v1[0], v1[1]); w.w = pk2(v1[2], v1[3]);
                    *(GAS u32x4*)(rp + c) = w; } }
    }
};
struct EpiResid {
    static constexpr bool PERM = true, AFTER_DRAIN = false;
    bf16_t* HB; int ld; float* ss;
    __device__ __forceinline__ void operator()(const f32x4 (&acc)[2][2][4][2], const Unit& u, int wr, int wc, int fr, int fq) const {
        const int row0 = u.pm * BM + wr * 64 + fr; const int c0 = u.pn * BM + wc * 32 + 8 * fq;
#pragma unroll
        for (int ai = 0; ai < 2; ++ai)
#pragma unroll
            for (int m = 0; m < 4; ++m) { const int row = row0 + ai * HALF + m * 16; bf16_t* bp = HB + (size_t)row * ld + c0; float sq = 0.f;
#pragma unroll
                for (int bj = 0; bj < 2; ++bj) { GAS u32x4* p = (GAS u32x4*)(bp + bj * HALF); const u32x4 h = *p; const f32x4 a0 = acc[ai][bj][m][0], a1 = acc[ai][bj][m][1];
                    const float v0 = __uint_as_float(h.x << 16) + a0[0], v1 = __uint_as_float(h.x & 0xffff0000u) + a0[1], v2 = __uint_as_float(h.y << 16) + a0[2], v3 = __uint_as_float(h.y & 0xffff0000u) + a0[3];
                    const float v4 = __uint_as_float(h.z << 16) + a1[0], v5 = __uint_as_float(h.z & 0xffff0000u) + a1[1], v6 = __uint_as_float(h.w << 16) + a1[2], v7 = __uint_as_float(h.w & 0xffff0000u) + a1[3];
                    u32x4 w; w.x = pk2(v0, v1); w.y = pk2(v2, v3); w.z = pk2(v4, v5); w.w = pk2(v6, v7); *p = w;
                    sq += ((v0 * v0 + v1 * v1) + (v2 * v2 + v3 * v3)) + ((v4 * v4 + v5 * v5) + (v6 * v6 + v7 * v7)); }
                sq += __int_as_float(__builtin_amdgcn_ds_swizzle(__float_as_int(sq), (16 << 10) | 0x1f));
                { auto rr = __builtin_amdgcn_permlane32_swap(__float_as_uint(sq), __float_as_uint(sq), false, false); sq = __uint_as_float(rr[0]) + __uint_as_float(rr[1]); }
                if (fq == 0) ss[(size_t)row * 16 + u.pn * 4 + wc] = sq; }
    }
};
struct EpiGate {
    static constexpr bool PERM = true, AFTER_DRAIN = false;
    const bf16_t* XC; bf16_t* A; bf16_t* U; const float* rb; const float* ib; const float* lam;
    __device__ __forceinline__ void operator()(const f32x4 (&acc)[2][2][4][2], const Unit& u, int wr, int wc, int fr, int fq) const {
        const int row0 = u.pm * BM + wr * 64 + fr; const int ch0 = u.pn * 128 + wc * 32 + 8 * fq;
        f32x4 rb4[2], ib4[2], sp4[2];
#pragma unroll
        for (int n = 0; n < 2; ++n) { rb4[n] = *(GAS const f32x4*)(rb + ch0 + 4 * n); ib4[n] = *(GAS const f32x4*)(ib + ch0 + 4 * n); const f32x4 l4 = *(GAS const f32x4*)(lam + ch0 + 4 * n);
#pragma unroll
            for (int j = 0; j < 4; ++j) sp4[n][j] = -8.f * log1pf(expf(-l4[j])); }
#pragma unroll
        for (int ai = 0; ai < 2; ++ai)
#pragma unroll
            for (int m = 0; m < 4; ++m) { const size_t ro = (size_t)(row0 + ai * HALF + m * 16) * 512 + ch0; const u32x4 xw = *(GAS const u32x4*)(XC + ro);
                float xc[8]; xc[0] = __uint_as_float(xw.x << 16); xc[1] = __uint_as_float(xw.x & 0xffff0000u); xc[2] = __uint_as_float(xw.y << 16); xc[3] = __uint_as_float(xw.y & 0xffff0000u);
                xc[4] = __uint_as_float(xw.z << 16); xc[5] = __uint_as_float(xw.z & 0xffff0000u); xc[6] = __uint_as_float(xw.w << 16); xc[7] = __uint_as_float(xw.w & 0xffff0000u);
                float av[8], uv[8];
#pragma unroll
                for (int n = 0; n < 2; ++n) { const f32x4 rp = acc[ai][0][m][n] + rb4[n], ip = acc[ai][1][m][n] + ib4[n];
#pragma unroll
                    for (int j = 0; j < 4; ++j) { const float r = __builtin_amdgcn_rcpf(1.f + __expf(-rp[j])), ig = __builtin_amdgcn_rcpf(1.f + __expf(-ip[j])); const float la = r * sp4[n][j];
                        const float a = expf(la); av[4 * n + j] = la; uv[4 * n + j] = __builtin_amdgcn_sqrtf(fmaxf(1.f - a * a, 0.f)) * ig * xc[4 * n + j]; } }
                u32x4 wa, wu; wa.x = pk2(av[0], av[1]); wa.y = pk2(av[2], av[3]); wa.z = pk2(av[4], av[5]); wa.w = pk2(av[6], av[7]);
                wu.x = pk2(uv[0], uv[1]); wu.y = pk2(uv[2], uv[3]); wu.z = pk2(uv[4], uv[5]); wu.w = pk2(uv[6], uv[7]);
                *(GAS u32x4*)(A + ro) = wa; *(GAS u32x4*)(U + ro) = wu; }
    }
};
struct EpiQ {
    static constexpr bool PERM = true, AFTER_DRAIN = false;
    bf16_t* Q; const float* cs; const float* sn; float scale;
    __device__ __forceinline__ void operator()(const f32x4 (&acc)[2][2][4][2], const Unit& u, int wr, int wc, int fr, int fq) const {
        const int row0 = u.pm * BM + wr * 64 + fr; const int cb = u.pn * BM + wc * 32;
#pragma unroll
        for (int ai = 0; ai < 2; ++ai)
#pragma unroll
            for (int m = 0; m < 4; ++m) { const int row = row0 + ai * HALF + m * 16; const int t = row % TT; bf16_t* rp = Q + (size_t)row * 1536;
#pragma unroll
                for (int bj = 0; bj < 2; ++bj) { const int c = cb + bj * HALF; f32x4 v0 = acc[ai][bj][m][0], v1 = acc[ai][bj][m][1];
                    if (((c >> 5) % 3) == 2) {
                        const float* cp = cs + t * 16 + 8 * (fq & 1); const float* sp = sn + t * 16 + 8 * (fq & 1);
                        const f32x4 c0 = *(const f32x4*)cp, c1 = *(GAS const f32x4*)(cp + 4), s0 = *(const f32x4*)sp, s1 = *(GAS const f32x4*)(sp + 4);
                        f32x4 o0, o1; const bool upper = (fq >= 2);
#pragma unroll
                        for (int j = 0; j < 4; ++j) {
                            const float a = v0[j], b = v1[j];
                            auto ra = __builtin_amdgcn_permlane32_swap(__float_as_uint(a), __float_as_uint(a), false, false); auto rbb = __builtin_amdgcn_permlane32_swap(__float_as_uint(b), __float_as_uint(b), false, false);
                            const float pa = __uint_as_float(upper ? ra[0] : ra[1]), pb = __uint_as_float(upper ? rbb[0] : rbb[1]);
                            o0[j] = upper ? (a * c0[j] + pa * s0[j]) : (a * c0[j] - pa * s0[j]);
                            o1[j] = upper ? (b * c1[j] + pb * s1[j]) : (b * c1[j] - pb * s1[j]);
                        }
                        v0 = o0; v1 = o1;
                    }
                    v0 = v0 * scale; v1 = v1 * scale; u32x4 w; w.x = pk2(v0[0], v0[1]); w.y = pk2(v0[2], v0[3]); w.z = pk2(v1[0], v1[1]); w.w = pk2(v1[2], v1[3]);
                    *(GAS u32x4*)(rp + c + 8 * fq) = w; } }
    }
};

template <int CTRL> __device__ __forceinline__ f32x2v dpp_ror(f32x2v v) { f32x2v r; const float x0 = v[0], x1 = v[1];
    r[0] = __int_as_float(__builtin_amdgcn_mov_dpp(__float_as_int(x0), CTRL, 0xf, 0xf, true)); r[1] = __int_as_float(__builtin_amdgcn_mov_dpp(__float_as_int(x1), CTRL, 0xf, 0xf, true)); return r; }
struct EpiUp {
    static constexpr bool PERM = true, AFTER_DRAIN = false;
    bf16_t* G; const float* cw; const float* cb; PG8_LAS float* halo; int Mrows; const float* ss;
    __device__ __forceinline__ void operator()(const f32x4 (&acc)[2][2][4][2], const Unit& u, int wr, int wc, int fr, int fq) const {
        const int rb = u.pm * 254 - 2;
        float rs[2][4]; unsigned flags = 0;
#pragma unroll
        for (int ai = 0; ai < 2; ++ai)
#pragma unroll
            for (int m = 0; m < 4; ++m) { const int lrow = 128 * ai + 64 * wr + 16 * m + fr; const int row = rb + lrow; const int rc = row < 0 ? 0 : (row >= Mrows ? Mrows - 1 : row);
                rs[ai][m] = row_rstd(ss, rc, fq); const int t = rc % TT;
                const unsigned f = ((lrow >= 2 && row < Mrows) ? 1u : 0u) | ((t == 0) ? 2u : 0u) | ((t <= 1) ? 4u : 0u); flags |= f << (3 * (ai * 4 + m)); }
        {
            const int t2 = 2 * (((wr * 4 + wc) * 64) + fq * 16 + fr); const int k_ = t2 >> 8, bj_ = (t2 >> 7) & 1, cc_ = t2 & 127;
            const float* src_ = (k_ < 3 ? cw + k_ * 5632 : cb) + bj_ * 2816 + u.pn * 128 + cc_;
            *(PG8_LAS f32x2v*)(halo + 2048 + t2) = *(GAS const f32x2v*)src_; }
        if (fr >= 14) {
#pragma unroll
            for (int ai = 0; ai < 2; ++ai) { PG8_LAS float* hw = halo + ((((2 * ai + wr) * 2 + (fr - 14)) * 4 + wc) * 64) + fq * 4;
#pragma unroll
                for (int bj = 0; bj < 2; ++bj)
#pragma unroll
                    for (int n = 0; n < 2; ++n) *(PG8_LAS f32x4*)(hw + (bj * 2 + n) * 16) = acc[ai][bj][3][n] * rs[ai][3]; }
        }
        asm volatile("s_waitcnt lgkmcnt(0)\n\ts_barrier" ::: "memory");
        const bool bstart = __any((flags & 0xDB6DB6u) != 0u);
        const bool allemit = __all((flags & 0x249249u) == 0x249249u);
        const f32x2v zero = {0.f, 0.f};
#pragma unroll
        for (int nn = 0; nn < 4; ++nn) {
            const int n = nn >> 1, jh = nn & 1;
            const int ca0 = u.pn * 128 + wc * 32 + 8 * fq + 4 * n + 2 * jh;
            PG8_LAS const float* wl = halo + 2048 + wc * 32 + 8 * fq + 4 * n + 2 * jh;
            const f32x2v wA0 = *(PG8_LAS const f32x2v*)(wl), wA1 = *(PG8_LAS const f32x2v*)(wl + 256), wA2 = *(PG8_LAS const f32x2v*)(wl + 512), bA = *(PG8_LAS const f32x2v*)(wl + 768);
            const f32x2v wG0 = *(PG8_LAS const f32x2v*)(wl + 128), wG1 = *(PG8_LAS const f32x2v*)(wl + 256 + 128), wG2 = *(PG8_LAS const f32x2v*)(wl + 512 + 128), bG = *(PG8_LAS const f32x2v*)(wl + 768 + 128);
#pragma unroll
            for (int ai = 0; ai < 2; ++ai) {
                const int s = 2 * ai + wr;
                f32x2v cA1 = zero, cA2 = zero, cG1 = zero, cG2 = zero;
                if (s > 0) { PG8_LAS const float* hr = halo + ((((s - 1) * 2) * 4 + wc) * 64) + fq * 4 + n * 16 + 2 * jh;
                    const f32x2v a2 = *(PG8_LAS const f32x2v*)(hr), a1 = *(PG8_LAS const f32x2v*)(hr + 256), g2 = *(PG8_LAS const f32x2v*)(hr + 32), g1 = *(PG8_LAS const f32x2v*)(hr + 256 + 32);
                    cA1 = a1; cG1 = g1; cA2 = (fr == 0) ? a2 : a1; cG2 = (fr == 0) ? g2 : g1; }
#pragma unroll
                for (int m = 0; m < 4; ++m) {
                    const f32x4 ua4 = acc[ai][0][m][n], ug4 = acc[ai][1][m][n]; const float rsm = rs[ai][m];
                    const f32x2v ua = {ua4[2 * jh] * rsm, ua4[2 * jh + 1] * rsm}, ug = {ug4[2 * jh] * rsm, ug4[2 * jh + 1] * rsm};
                    const f32x2v rA1 = dpp_ror<0x121>(ua), rA2 = dpp_ror<0x122>(ua), rG1 = dpp_ror<0x121>(ug), rG2 = dpp_ror<0x122>(ug);
                    f32x2v pA1 = (fr >= 1) ? rA1 : cA1, pA2 = (fr >= 2) ? rA2 : cA2, pG1 = (fr >= 1) ? rG1 : cG1, pG2 = (fr >= 2) ? rG2 : cG2;
                    const int row = rb + 128 * ai + 64 * wr + 16 * m + fr; const unsigned f = flags >> (3 * (ai * 4 + m));
                    if (bstart) { if (f & 2u) { pA1 = zero; pG1 = zero; }
                                  if (f & 4u) { pA2 = zero; pG2 = zero; } }
                    const f32x2v va = wA0 * pA2 + wA1 * pA1 + wA2 * ua + bA, vg = wG0 * pG2 + wG1 * pG1 + wG2 * ug + bG;
                    const float o0 = va[0] * __builtin_amdgcn_rcpf(1.f + __expf(-va[0])) * vg[0], o1 = va[1] * __builtin_amdgcn_rcpf(1.f + __expf(-va[1])) * vg[1];
                    if (allemit) *(GAS unsigned*)(G + (size_t)row * 2816 + ca0) = pk2(o0, o1);
                    else if (f & 1u) *(GAS unsigned*)(G + (size_t)row * 2816 + ca0) = pk2(o0, o1);
                    cA1 = rA1; cA2 = rA2; cG1 = rG1; cG2 = rG2;
                }
            }
        }
    }
};
struct EpiAny {
    static constexpr bool PERM = true, AFTER_DRAIN = false;
    int kind; void* p0; void* p1; void* p2; const float* f0; const float* f1; const float* f2; int i0, i1, i2; float scale; PG8_LAS float* halo;
    __device__ __forceinline__ void operator()(const f32x4 (&acc)[2][2][4][2], const Unit& u, int wr, int wc, int fr, int fq) const {
        if (kind == 0) { EpiStore<0> e{(bf16_t*)p0, i0, (bf16_t*)p1, i1, i2, f2}; e(acc, u, wr, wc, fr, fq); }
        else if (kind == 1) { EpiStore<1> e{(bf16_t*)p0, i0, (bf16_t*)p0, i0, 1 << 30, nullptr}; e(acc, u, wr, wc, fr, fq); }
        else if (kind == 6) { EpiStore<2> e{(bf16_t*)p0, i0, (bf16_t*)p0, i0, 1 << 30, nullptr}; e(acc, u, wr, wc, fr, fq); }
        else if (kind == 2) { EpiResid e{(bf16_t*)p1, i0, (float*)p2}; e(acc, u, wr, wc, fr, fq); }
        else if (kind == 3) { EpiGate e{(const bf16_t*)p1, (bf16_t*)p0, (bf16_t*)p2, f0, f1, f2}; e(acc, u, wr, wc, fr, fq); }
        else if (kind == 4) { EpiQ e{(bf16_t*)p0, f0, f1, scale}; e(acc, u, wr, wc, fr, fq); }
        else if (kind == 5) { EpiUp e{(bf16_t*)p0, f0, f1, halo, i0, f2}; e(acc, u, wr, wc, fr, fq); }
        else if (kind == 8) {
            int rz = 0; asm volatile("" : "+v"(rz));
            float* T = (float*)p0 + (size_t)u.pm * ((size_t)256 * i0); const int c0 = u.pn * BM + wc * 32 + 8 * fq;
#pragma unroll
            for (int ai = 0; ai < 2; ++ai)
#pragma unroll
                for (int m = 0; m < 4; ++m) { float* rp = T + (size_t)(wr * 64 + fr + rz + ai * HALF + m * 16) * i0 + c0;
#pragma unroll
                    for (int bj = 0; bj < 2; ++bj)
#pragma unroll
                        for (int n = 0; n < 2; ++n) *(GAS f32x4*)(rp + bj * HALF + 4 * n) = acc[ai][bj][m][n]; }
        }
        else { if (acc[0][0][0][0][0] == 123456.789f) *(float*)p0 = 1.f; }
    }
};
template <class Epi, class Sched, bool ALIGN_EPI = false, bool SP2 = false>
__device__ __forceinline__ void gemm_phase(PG8_LAS unsigned char* lds, const Gemm g, const Sched& S, const Epi& E) {
    int tid0 = threadIdx.x; asm volatile("" : "+v"(tid0));
    const int tid = tid0, wid = __builtin_amdgcn_readfirstlane(tid >> 6), lane = tid & 63, wr = wid >> 2, wc = wid & 3, fr = lane & 15, fq = lane >> 4;
    const int K = g.K, nt = K / BK;
    unsigned voffA[2], voffB[2];
#pragma unroll
    for (int i = 0; i < 2; ++i) { int R, C; stage_rc(tid * 16 + i * 8192, R, C); const int Rb = Epi::PERM ? ((R & ~31) + perm32(R & 31)) : R;
        voffA[i] = (unsigned)(R * g.lda + C) * 2u; voffB[i] = (unsigned)(Rb * g.ldb + C) * 2u; }
    const size_t kstep = (size_t)(BK * 2);
    const size_t hstepA = (size_t)HALF * g.lda * 2, hstepB = (size_t)HALF * g.ldb * 2;
    const unsigned ldsw = (unsigned)wid * 1024u;
    const int aoff = lds_byte(wr * 64 + fr, fq * 8), boff = lds_byte(wc * 32 + fr, fq * 8);
#define PG8_SA(b, h) (((b) * 2 + (h)) * HTB)
#define PG8_SB(b, h) ((4 + (b) * 2 + (h)) * HTB)
#define PG8_STAGE(bufoff, gbase, voff) do { _Pragma("unroll") for (int _i = 0; _i < 2; ++_i) \
        __builtin_amdgcn_global_load_lds((const unsigned*)((const char*)(gbase) + (voff)[_i]), (PG8_LAS unsigned*)(lds + (bufoff) + ldsw + _i * 8192), 16, 0, 0); } while (0)
#define PG8_LDA(dst, b, h) do { _Pragma("unroll") for (int m = 0; m < 4; ++m) _Pragma("unroll") for (int k = 0; k < 2; ++k) dst[m][k] = *(const PG8_LAS bf16x8*)(lds + PG8_SA(b, h) + aoff + m * 2048 + k * 1024); } while (0)
#define PG8_LDB(dst, b, h) do { _Pragma("unroll") for (int n = 0; n < 2; ++n) _Pragma("unroll") for (int k = 0; k < 2; ++k) dst[n][k] = *(const PG8_LAS bf16x8*)(lds + PG8_SB(b, h) + boff + n * 2048 + k * 1024); } while (0)
#define PG8_MMA(ai, bj, At, Bt) do { __builtin_amdgcn_s_setprio(1); _Pragma("unroll") for (int m = 0; m < 4; ++m) _Pragma("unroll") for (int n = 0; n < 2; ++n) _Pragma("unroll") for (int k = 0; k < 2; ++k) \
        acc[ai][bj][m][n] = __builtin_amdgcn_mfma_f32_16x16x32_bf16(Bt[n][k], At[m][k], acc[ai][bj][m][n], 0, 0, 0); __builtin_amdgcn_s_setprio(0); } while (0)
#define PG8_WAIT_V(n) asm volatile("s_waitcnt vmcnt(" #n ")" ::: "memory")
#define PG8_WAIT_L(n) asm volatile("s_waitcnt lgkmcnt(" #n ")" ::: "memory")
#define PG8_BAR __builtin_amdgcn_s_barrier()
#define PG8_SCHED __builtin_amdgcn_sched_barrier(0)
    Unit cur, nxt; int ui = 0;
    if (!S.next(0, cur)) return;
    f32x4 acc[2][2][4][2];
#pragma unroll
    for (int a = 0; a < 2; ++a)
#pragma unroll
        for (int b = 0; b < 2; ++b)
#pragma unroll
            for (int m = 0; m < 4; ++m)
#pragma unroll
                for (int n = 0; n < 2; ++n) acc[a][b][m][n] = (f32x4){0.f, 0.f, 0.f, 0.f};
    bf16x8 At[4][2], B0[2][2], B1[2][2];
    const char* cA = (const char*)g.A + (size_t)cur.pm * g.atstep + (size_t)cur.pn * g.a_pn; const char* cB = (const char*)g.Bt + (size_t)cur.pn * g.btstep + (size_t)cur.pm * g.b_pm;
    S.a_ready(cur);
    if constexpr (SP2) {
        PG8_STAGE(PG8_SB(0, 0), cB, voffB); PG8_STAGE(PG8_SB(0, 1), cB + hstepB, voffB); PG8_STAGE(PG8_SA(0, 0), cA, voffA); PG8_STAGE(PG8_SA(0, 1), cA + hstepA, voffA);
        if (wr == 1) PG8_BAR;
        PG8_WAIT_V(2); PG8_BAR;
        PG8_STAGE(PG8_SB(1, 0), cB + kstep, voffB); PG8_STAGE(PG8_SA(1, 0), cA + kstep, voffA); PG8_STAGE(PG8_SB(1, 1), cB + hstepB + kstep, voffB);
        PG8_WAIT_V(6); PG8_BAR;
    } else {
        PG8_STAGE(PG8_SB(0, 0), cB, voffB); PG8_STAGE(PG8_SA(0, 0), cA, voffA); PG8_STAGE(PG8_SB(0, 1), cB + hstepB, voffB); PG8_STAGE(PG8_SA(0, 1), cA + hstepA, voffA);
        if (wr == 1) PG8_BAR;
        PG8_WAIT_V(4); PG8_BAR;
        PG8_STAGE(PG8_SB(1, 0), cB + kstep, voffB); PG8_STAGE(PG8_SA(1, 0), cA + kstep, voffA); PG8_STAGE(PG8_SB(1, 1), cB + hstepB + kstep, voffB);
        PG8_WAIT_V(6); PG8_BAR;
    }
    for (;;) {
        const bool has_next = S.next(ui + 1, nxt);
        const char* nA = has_next ? (const char*)g.A + (size_t)nxt.pm * g.atstep + (size_t)nxt.pn * g.a_pn : cA; const char* nB = has_next ? (const char*)g.Bt + (size_t)nxt.pn * g.btstep + (size_t)nxt.pm * g.b_pm : cB;
        for (int t = 0; t < nt; t += 2) {
            const bool last = (t == nt - 2);
            const char* a1 = cA + (size_t)(t + 1) * kstep;
            const char* a2 = last ? nA : cA + (size_t)(t + 2) * kstep; const char* b2 = last ? nB : cB + (size_t)(t + 2) * kstep;
            const char* a3 = a2 + kstep; const char* b3 = b2 + kstep;
            if (last && has_next) S.a_ready(nxt);
            if constexpr (SP2) {
            PG8_LDB(B0, 0, 0); PG8_LDB(B1, 0, 1); PG8_SCHED; PG8_LDA(At, 0, 0); PG8_STAGE(PG8_SA(1, 1), a1 + hstepA, voffA);
            PG8_WAIT_V(8); PG8_WAIT_L(0); PG8_BAR; PG8_MMA(0, 0, At, B0); PG8_MMA(0, 1, At, B1); PG8_BAR; PG8_SCHED;
            PG8_LDA(At, 0, 1); PG8_STAGE(PG8_SB(0, 0), b2, voffB); PG8_STAGE(PG8_SB(0, 1), b2 + hstepB, voffB); PG8_STAGE(PG8_SA(0, 0), a2, voffA);
            PG8_WAIT_V(8); PG8_WAIT_L(0); PG8_BAR; PG8_MMA(1, 0, At, B0); PG8_MMA(1, 1, At, B1); PG8_BAR; PG8_SCHED;
            PG8_LDB(B0, 1, 0); PG8_LDB(B1, 1, 1); PG8_SCHED; PG8_LDA(At, 1, 0); PG8_STAGE(PG8_SA(0, 1), a2 + hstepA, voffA);
            PG8_WAIT_V(8); PG8_WAIT_L(0); PG8_BAR; PG8_MMA(0, 0, At, B0); PG8_MMA(0, 1, At, B1); PG8_BAR; PG8_SCHED;
            PG8_LDA(At, 1, 1); PG8_STAGE(PG8_SB(1, 0), b3, voffB); PG8_STAGE(PG8_SB(1, 1), b3 + hstepB, voffB); PG8_STAGE(PG8_SA(1, 0), a3, voffA);
            PG8_WAIT_V(8); PG8_WAIT_L(0); PG8_BAR; PG8_MMA(1, 0, At, B0); PG8_MMA(1, 1, At, B1); PG8_BAR; PG8_SCHED;
            } else {
            PG8_LDB(B0, 0, 0); PG8_SCHED; PG8_LDA(At, 0, 0); PG8_STAGE(PG8_SA(1, 1), a1 + hstepA, voffA);
            PG8_WAIT_L(8); PG8_BAR; PG8_WAIT_L(0); PG8_MMA(0, 0, At, B0); PG8_BAR; PG8_SCHED;
            PG8_LDB(B1, 0, 1); PG8_STAGE(PG8_SB(0, 0), b2, voffB);
            PG8_BAR; PG8_WAIT_L(0); PG8_MMA(0, 1, At, B1); PG8_BAR;
            PG8_LDA(At, 0, 1); PG8_STAGE(PG8_SA(0, 0), a2, voffA);
            PG8_BAR; PG8_WAIT_L(0); PG8_MMA(1, 0, At, B0); PG8_BAR; PG8_SCHED;
            PG8_STAGE(PG8_SB(0, 1), b2 + hstepB, voffB);
            PG8_WAIT_V(6); PG8_BAR; PG8_MMA(1, 1, At, B1); PG8_BAR;
            PG8_LDB(B0, 1, 0); PG8_SCHED; PG8_LDA(At, 1, 0); PG8_STAGE(PG8_SA(0, 1), a2 + hstepA, voffA);
            PG8_WAIT_L(8); PG8_BAR; PG8_WAIT_L(0); PG8_MMA(0, 0, At, B0); PG8_BAR; PG8_SCHED;
            PG8_LDB(B1, 1, 1); PG8_STAGE(PG8_SB(1, 0), b3, voffB);
            PG8_BAR; PG8_WAIT_L(0); PG8_MMA(0, 1, At, B1); PG8_BAR;
            PG8_LDA(At, 1, 1); PG8_STAGE(PG8_SA(1, 0), a3, voffA);
            PG8_BAR; PG8_WAIT_L(0); PG8_MMA(1, 0, At, B0); PG8_BAR; PG8_SCHED;
            PG8_STAGE(PG8_SB(1, 1), b3 + hstepB, voffB);
            PG8_WAIT_V(6); PG8_BAR; PG8_MMA(1, 1, At, B1); PG8_BAR;
            }
        }
        if constexpr (ALIGN_EPI) { if (wr == 0) PG8_BAR; }
        if constexpr (!Epi::AFTER_DRAIN) { E(acc, cur, wr, wc, fr, fq); S.done(cur); }
        if (!has_next) break;
#pragma unroll
        for (int a = 0; a < 2; ++a)
#pragma unroll
            for (int b = 0; b < 2; ++b)
#pragma unroll
                for (int m = 0; m < 4; ++m)
#pragma unroll
                    for (int n = 0; n < 2; ++n) acc[a][b][m][n] = (f32x4){0.f, 0.f, 0.f, 0.f};
        cur = nxt; cA = nA; cB = nB; ++ui;
        if constexpr (ALIGN_EPI) { if (wr == 1) PG8_BAR; }
    }
    PG8_WAIT_V(0);
    if constexpr (!ALIGN_EPI) { if (wr == 0) PG8_BAR; }
    PG8_BAR;
    if constexpr (Epi::AFTER_DRAIN) { E.fused(acc, cur, wr, wc, fr, fq, lds, wid, lane); S.done(cur); }
#undef PG8_SA
#undef PG8_SB
#undef PG8_STAGE
#undef PG8_LDA
#undef PG8_LDB
#undef PG8_MMA
#undef PG8_WAIT_V
#undef PG8_WAIT_L
#undef PG8_BAR
#undef PG8_SCHED
}
}
#define DI __device__ __forceinline__
#define LAS __attribute__((address_space(3)))
#define GAS __attribute__((address_space(1)))
using pg8::bf16_t; using pg8::bf16x8; using pg8::f32x4; using pg8::u32x4; using pg8::u32x2; using pg8::pk2; using pg8::f32x2v;
typedef float f32x16 __attribute__((ext_vector_type(16)));
constexpr int TT = pg8::TT, NB = 16, M = NB * TT, DM = 1024, SEQ = 4096;
constexpr int NTILE = M / 256;
constexpr float EPS = 1e-6f;
constexpr size_t MiB = 1u << 20;
constexpr size_t WS_EVIN = 0, WS_EVG = 10 * MiB, WS_EVOUT = 12 * MiB, WS_ODIN = 16 * MiB, WS_UQ = 19 * MiB, WS_UK = 22 * MiB, WS_UV = 23 * MiB, WS_ODOUT = 24 * MiB,
                 WS_UP = 28 * MiB, WS_DOWN = 72 * MiB, WS_COS = 94 * MiB, WS_SIN = 94 * MiB + 512 * 1024, WS_AGG = 95 * MiB, WS_H = 104 * MiB, WS_HB = WS_H + 4096, WS_R = 361 * MiB;
constexpr size_t SZ_EVIN = (size_t)2560 * 1024 * 2, SZ_EVG = (size_t)1024 * 512 * 2, SZ_EVOUT = (size_t)1024 * 1024 * 2, SZ_ODIN = (size_t)768 * 1024 * 2, SZ_UQ = (size_t)1536 * 384 * 2,
                 SZ_UK = (size_t)1024 * 256 * 2, SZ_ODOUT = SZ_EVOUT, SZ_UP = (size_t)5632 * 1024 * 2, SZ_DOWN = (size_t)1024 * 2816 * 2;
constexpr size_t R_U1 = 0, R_GATE = 257 * MiB, R_XC = 322 * MiB, R_Y = 387 * MiB, R_A = 0, R_UU = (size_t)M * 512 * 4;
constexpr size_t R_Q = 0, R_K = 193 * MiB, R_VT = 386 * MiB, R_U2 = R_VT, R_O = 517 * MiB;
constexpr size_t R_G = 0;
constexpr size_t WS_NEED = WS_R + 646 * MiB;
constexpr size_t DO_T = 212 * MiB;
constexpr size_t WS_SS = 97 * MiB;
constexpr size_t DO_HN = 4096, DO_CQN = 129 * MiB, DO_CKVN = 178 * MiB;
constexpr int LDS_BYTES = 131072 + 8192 + 4096;
constexpr int FFN_SPLIT = 129;

struct Params { const float* in[26]; float* out; unsigned char* ws; int ph_lo, ph_hi; };
typedef const __attribute__((address_space(4))) Params* KParams;

DI float bflo(unsigned w) { return __uint_as_float(w << 16); }
DI float bfhi(unsigned w) { return __uint_as_float(w & 0xffff0000u); }
DI void unpack8(const u32x4 w, float* f) { f[0] = bflo(w.x); f[1] = bfhi(w.x); f[2] = bflo(w.y); f[3] = bfhi(w.y); f[4] = bflo(w.z); f[5] = bfhi(w.z); f[6] = bflo(w.w); f[7] = bfhi(w.w); }
DI u32x4 pack8(const float* f) { u32x4 w; w.x = pk2(f[0], f[1]); w.y = pk2(f[2], f[3]); w.z = pk2(f[4], f[5]); w.w = pk2(f[6], f[7]); return w; }
template <int MASK> DI float swz_xor(float v) { return __int_as_float(__builtin_amdgcn_ds_swizzle(__float_as_int(v), (MASK << 10) | 0x1f)); }
DI float half_sum(float v) { auto rr = __builtin_amdgcn_permlane32_swap(__float_as_uint(v), __float_as_uint(v), false, false); return __uint_as_float(rr[0]) + __uint_as_float(rr[1]); }
DI float half_max(float v) { auto rr = __builtin_amdgcn_permlane32_swap(__float_as_uint(v), __float_as_uint(v), false, false); return fmaxf(__uint_as_float(rr[0]), __uint_as_float(rr[1])); }
DI float wave_sum(float v) { v += swz_xor<1>(v); v += swz_xor<2>(v); v += swz_xor<4>(v); v += swz_xor<8>(v); v += swz_xor<16>(v); return half_sum(v); }
DI float bf1(const bf16_t* p) { return __uint_as_float((unsigned)(*(GAS const bf16_t*)p) << 16); }
DI bf16_t tobf(float f) { return (bf16_t)(pk2(f, 0.f) & 0xffffu); }

DI int otid() { int t = threadIdx.x; asm volatile("" : "+v"(t)); return t; }
DI int obid() { int b = blockIdx.x; asm volatile("" : "+s"(b)); return b; }
template <class F> DI void cvt_wT(const float* W, int K, int Ns, bf16_t* Wt, int Nd, F smap, float* sl, const float* gsc = nullptr) {
    const int tid = otid(), tn = Nd / 64, tk = K / 64, total = tn * tk;
    for (int it = obid(); it < total; it += gridDim.x) {
        const int n0 = (it % tn) * 64, k0 = (it / tn) * 64; const int s0 = smap(n0);
        const int j = tid & 63, i = tid >> 6;
        __syncthreads();
#pragma unroll
        for (int r = 0; r < 8; ++r) { const int k = k0 + i * 8 + r; float v = 0.f; if (s0 >= 0 && s0 + j < Ns) v = W[(size_t)k * Ns + s0 + j]; if (gsc) v *= gsc[k]; sl[(i * 8 + r) * 65 + j] = v; }
        __syncthreads();
        const int nl = tid >> 3, kc = tid & 7; float f[8];
#pragma unroll
        for (int e = 0; e < 8; ++e) f[e] = sl[(kc * 8 + e) * 65 + nl];
        *(GAS u32x4*)(Wt + (size_t)(n0 + nl) * K + k0 + kc * 8) = pack8(f);
    }
    __syncthreads();
}
struct MapId { DI int operator()(int n0) const { return n0; } };
struct MapK { DI int operator()(int n0) const { return (n0 >> 6) * 128; } };
struct MapUp { DI int operator()(int n0) const { return ((n0 >> 7) & 1) * 2816 + (n0 >> 8) * 128 + (n0 & 127); } };
struct MapV { DI int operator()(int n0) const { return (n0 >> 6) * 128 + 64; } };

DI void sincos_r(float ang, float& c, float& s) {
    const float n = rintf(ang * 0.15915494309189535f);
    float r = fmaf(-n, 6.28125f, ang); r = fmaf(-n, 1.9353071795864769e-3f, r);
    c = __cosf(r); s = __sinf(r);
}
DI void phase_prologue(KParams P, float* sl) {
    unsigned char* ws = P->ws;
    for (int j = 0; j < 2; ++j) {
        cvt_wT(P->in[3] + (size_t)j * 1024 * 2560, 1024, 2560, (bf16_t*)(ws + WS_EVIN + j * SZ_EVIN), 2560, MapId(), sl, P->in[2] + j * 1024);
        cvt_wT(P->in[12] + (size_t)j * 1024 * 1024, 1024, 1024, (bf16_t*)(ws + WS_EVOUT + j * SZ_EVOUT), 1024, MapId(), sl);
        cvt_wT(P->in[14] + (size_t)j * 1024 * 672, 1024, 672, (bf16_t*)(ws + WS_ODIN + j * SZ_ODIN), 768, MapId(), sl, P->in[13] + j * 1024);
        cvt_wT(P->in[17] + (size_t)j * 384 * 1536, 384, 1536, (bf16_t*)(ws + WS_UQ + j * SZ_UQ), 1536, MapId(), sl);
        cvt_wT(P->in[18] + (size_t)j * 256 * 2048, 256, 2048, (bf16_t*)(ws + WS_UK + j * SZ_UK), 1024, MapK(), sl);
        cvt_wT(P->in[18] + (size_t)j * 256 * 2048, 256, 2048, (bf16_t*)(ws + WS_UV + j * SZ_UK), 1024, MapV(), sl);
        cvt_wT(P->in[19] + (size_t)j * 1024 * 1024, 1024, 1024, (bf16_t*)(ws + WS_ODOUT + j * SZ_ODOUT), 1024, MapId(), sl);
    }
    for (int l = 0; l < 4; ++l) {
        cvt_wT(P->in[21] + (size_t)l * 1024 * 5632, 1024, 5632, (bf16_t*)(ws + WS_UP + l * SZ_UP), 5632, MapUp(), sl, P->in[20] + l * 1024);
        cvt_wT(P->in[24] + (size_t)l * 2816 * 1024, 2816, 1024, (bf16_t*)(ws + WS_DOWN + l * SZ_DOWN), 1024, MapId(), sl);
    }
    const int gtid = obid() * 512 + otid(), nth = gridDim.x * 512;
    for (int idx = gtid; idx < 2 * 1024 * 64; idx += nth) {
        const int j = idx >> 16, rem = idx & 65535, n = rem >> 6, k0 = (rem & 63) * 8;
        const int pn = n >> 8, bj = (n >> 7) & 1, ch = pn * 128 + (n & 127), h = ch >> 6, jj = ch & 63;
        const float* src = (bj ? P->in[9] : P->in[7]) + (size_t)(j * 8 + h) * 4096;
        float f[8];
#pragma unroll
        for (int e = 0; e < 8; ++e) { const int k = k0 + e; f[e] = ((k >> 6) == h) ? src[(k & 63) * 64 + jj] : 0.f; }
        *(GAS u32x4*)((bf16_t*)(ws + WS_EVG + j * SZ_EVG) + (size_t)n * 512 + k0) = pack8(f);
    }
    { bf16_t* HB = (bf16_t*)(ws + WS_HB); float* ss0 = (float*)(ws + WS_SS);
      const int lane = otid() & 63, gw = obid() * 8 + (otid() >> 6), nw = gridDim.x * 8;
      for (int row = gw; row < M; row += nw) {
          const int b = row / TT, t = row % TT;
          GAS const f32x4* src = (GAS const f32x4*)((t < 16) ? P->in[1] + (size_t)t * 1024 : P->in[0] + ((size_t)b * SEQ + (t - 16)) * 1024);
          GAS u32x2* bp = (GAS u32x2*)(HB + (size_t)row * 1024); float sq = 0.f;
#pragma unroll
          for (int i = 0; i < 4; ++i) { const f32x4 v = src[lane + 64 * i]; u32x2 w; w.x = pk2(v[0], v[1]); w.y = pk2(v[2], v[3]); bp[lane + 64 * i] = w;
              sq += (v[0] * v[0] + v[1] * v[1]) + (v[2] * v[2] + v[3] * v[3]); }
          sq = wave_sum(sq); if (lane < 16) ss0[(size_t)row * 16 + lane] = (lane == 0) ? sq : 0.f;
      } }
    float* cs = (float*)(ws + WS_COS); float* sn = (float*)(ws + WS_SIN);
    for (int idx = gtid; idx < TT * 16; idx += nth) {
        const int t = idx >> 4, i = idx & 15;
        const float bb = ((i & 3) == 0) ? 1.0f : ((i & 3) == 1) ? 0.5623413251903491f : ((i & 3) == 2) ? 0.31622776601683794f : 0.1778279410038923f;
        const int e = i >> 2; const float sc = (e == 0) ? 1.0f : (e == 1) ? 0.1f : (e == 2) ? 0.01f : 0.001f;
        const float inv = bb * sc; const float ang = (float)t * inv;
        float c, s; sincos_r(ang, c, s); cs[idx] = c; sn[idx] = s;
    }
}

DI void phase_final(const bf16_t* HB, const float* g, float* out) {
    const int lane = otid() & 63, gw = obid() * 8 + (otid() >> 6), nw = gridDim.x * 8;
    f32x4 g4[4];
#pragma unroll
    for (int i = 0; i < 4; ++i) g4[i] = ((const f32x4*)g)[lane + 64 * i];
    for (int r = gw; r < NB * SEQ; r += nw) {
        const int b = r >> 12, s = r & 4095; const int row = b * TT + 16 + s;
        GAS const u32x2* p = (GAS const u32x2*)(HB + (size_t)row * 1024); f32x4 v[4]; float ss = 0.f;
#pragma unroll
        for (int i = 0; i < 4; ++i) { const u32x2 w = p[lane + 64 * i]; v[i][0] = bflo(w.x); v[i][1] = bfhi(w.x); v[i][2] = bflo(w.y); v[i][3] = bfhi(w.y);
            ss += (v[i][0] * v[i][0] + v[i][1] * v[i][1]) + (v[i][2] * v[i][2] + v[i][3] * v[i][3]); }
        const float rstd = rsqrtf(wave_sum(ss) * (1.f / 1024) + EPS);
        GAS f32x4* o = (GAS f32x4*)(out + (size_t)r * 1024);
#pragma unroll
        for (int i = 0; i < 4; ++i) o[lane + 64 * i] = v[i] * rstd * g4[i];
    }
}

DI void phase_evconv(const bf16_t* U1, const float* ca, const float* cb, const float* cbias, bf16_t* Y, bf16_t* XC) {
    const int lane = otid() & 63, gw = obid() * 8 + (otid() >> 6), nw = gridDim.x * 8; const int c8 = lane * 8;
    float wa[3][8], wb[4][8], bs[8];
#pragma unroll
    for (int k = 0; k < 3; ++k)
#pragma unroll
        for (int e = 0; e < 8; ++e) wa[k][e] = ca[k * 512 + c8 + e];
#pragma unroll
    for (int k = 0; k < 4; ++k)
#pragma unroll
        for (int e = 0; e < 8; ++e) wb[k][e] = cb[k * 512 + c8 + e];
#pragma unroll
    for (int e = 0; e < 8; ++e) bs[e] = cbias[c8 + e];
    for (int ri = gw; ri < M / 16; ri += nw) {
        const int r0 = ri * 16, t0 = r0 % TT;
        float p1[8], p2[8], x1[8], x2[8], x3[8];
#pragma unroll
        for (int e = 0; e < 8; ++e) { p1[e] = p2[e] = x1[e] = x2[e] = x3[e] = 0.f; }
        if (t0 != 0) {
            float a[8], b[8];
            const bf16_t* q1 = U1 + (size_t)(r0 - 1) * 2048 + c8; const bf16_t* q2 = U1 + (size_t)(r0 - 2) * 2048 + c8; const bf16_t* q3 = U1 + (size_t)(r0 - 3) * 2048 + c8;
            unpack8(*(GAS const u32x4*)(q1 + 512), a); unpack8(*(GAS const u32x4*)(q1 + 1024), b);
#pragma unroll
            for (int e = 0; e < 8; ++e) p1[e] = a[e] * b[e];
            unpack8(*(GAS const u32x4*)(q2 + 512), a); unpack8(*(GAS const u32x4*)(q2 + 1024), b);
#pragma unroll
            for (int e = 0; e < 8; ++e) p2[e] = a[e] * b[e];
            unpack8(*(GAS const u32x4*)(q1 + 1536), x1); unpack8(*(GAS const u32x4*)(q2 + 1536), x2); unpack8(*(GAS const u32x4*)(q3 + 1536), x3);
        }
        for (int rr = 0; rr < 16; ++rr) {
            const size_t row = (size_t)(r0 + rr); const bf16_t* q = U1 + row * 2048 + c8;
            float gb[8], gc[8], xa[8], x0[8], p0[8], ya[8], xc[8];
            unpack8(*(GAS const u32x4*)(q), gb); unpack8(*(GAS const u32x4*)(q + 512), gc); unpack8(*(GAS const u32x4*)(q + 1024), xa); unpack8(*(GAS const u32x4*)(q + 1536), x0);
#pragma unroll
            for (int e = 0; e < 8; ++e) {
                p0[e] = gc[e] * xa[e];
                ya[e] = gb[e] * (wa[0][e] * p2[e] + wa[1][e] * p1[e] + wa[2][e] * p0[e]);
                xc[e] = wb[0][e] * x3[e] + wb[1][e] * x2[e] + wb[2][e] * x1[e] + wb[3][e] * x0[e] + bs[e];
                p2[e] = p1[e]; p1[e] = p0[e]; x3[e] = x2[e]; x2[e] = x1[e]; x1[e] = x0[e];
            }
            *(GAS u32x4*)(Y + row * 1024 + c8) = pack8(ya); *(GAS u32x4*)(XC + row * 512 + c8) = pack8(xc);
        }
    }
}

DI void phase_scan1(const bf16_t* A, const bf16_t* U, float* agg) {
    const int ch = otid();
    for (int it = obid(); it < 256; it += gridDim.x) {
        const int b = it >> 4, c = it & 15; const size_t base = ((size_t)b * TT + (size_t)c * 257) * 512 + ch;
        float Pl = 0.f, S = 0.f;
        for (int s0 = 0; s0 < 256; s0 += 8) {
            float a[8], u[8];
#pragma unroll
            for (int e = 0; e < 8; ++e) { a[e] = bf1(A + base + (size_t)(s0 + e) * 512); u[e] = bf1(U + base + (size_t)(s0 + e) * 512); }
#pragma unroll
            for (int e = 0; e < 8; ++e) { S = __expf(a[e]) * S + u[e]; Pl += a[e]; }
        }
        { const float a = bf1(A + base + (size_t)256 * 512), u = bf1(U + base + (size_t)256 * 512); S = __expf(a) * S + u; Pl += a; }
        agg[((size_t)it * 512 + ch) * 2] = __expf(Pl); agg[((size_t)it * 512 + ch) * 2 + 1] = S;
    }
}
DI float gelu_tanh(float x) { const float u = 0.7978845608028654f * (x + 0.044715f * x * x * x); const float e = __expf(2.f * u); const float th = 1.f - 2.f / (e + 1.f); return 0.5f * x * (1.f + th); }
DI void phase_scan2(const bf16_t* A, const bf16_t* U, const float* agg, const bf16_t* GATE, bf16_t* Y) {
    const int ch = otid();
    for (int it = obid(); it < 256; it += gridDim.x) {
        const int b = it >> 4, c = it & 15; const size_t row0 = (size_t)b * TT + (size_t)c * 257; const size_t base = row0 * 512 + ch;
        float h = 0.f;
        for (int cc = 0; cc < c; ++cc) { const float Pp = agg[((size_t)(b * 16 + cc) * 512 + ch) * 2], S = agg[((size_t)(b * 16 + cc) * 512 + ch) * 2 + 1]; h = Pp * h + S; }
        for (int s0 = 0; s0 < 256; s0 += 8) {
            float a[8], u[8], g[8];
#pragma unroll
            for (int e = 0; e < 8; ++e) { a[e] = bf1(A + base + (size_t)(s0 + e) * 512); u[e] = bf1(U + base + (size_t)(s0 + e) * 512); g[e] = bf1(GATE + base + (size_t)(s0 + e) * 512); }
#pragma unroll
            for (int e = 0; e < 8; ++e) { h = __expf(a[e]) * h + u[e]; Y[(row0 + s0 + e) * 1024 + 512 + ch] = tobf(gelu_tanh(g[e]) * h); }
        }
        { const float a = bf1(A + base + (size_t)256 * 512), u = bf1(U + base + (size_t)256 * 512), g = bf1(GATE + base + (size_t)256 * 512); h = __expf(a) * h + u; Y[(row0 + 256) * 1024 + 512 + ch] = tobf(gelu_tanh(g) * h); }
    }
}

DI void phase_oddnorm(const bf16_t* U2, const float* qn, const float* kvn, const float* cs, const float* sn, bf16_t* CQN, bf16_t* CKVN, bf16_t* K) {
    const int lane = otid() & 63, gw = obid() * 8 + (otid() >> 6), nw = gridDim.x * 8;
    float gq[6], gk[4];
#pragma unroll
    for (int e = 0; e < 6; ++e) gq[e] = qn[lane * 6 + e];
#pragma unroll
    for (int e = 0; e < 4; ++e) gk[e] = kvn[lane * 4 + e];
    for (int row = gw; row < M; row += nw) {
        const bf16_t* u = U2 + (size_t)row * 768; const int t = row % TT;
        GAS const unsigned* uq = (GAS const unsigned*)(u + lane * 6); const unsigned w0 = uq[0], w1 = uq[1], w2 = uq[2];
        float q[6] = {bflo(w0), bfhi(w0), bflo(w1), bfhi(w1), bflo(w2), bfhi(w2)};
        float ss = 0.f;
#pragma unroll
        for (int e = 0; e < 6; ++e) ss += q[e] * q[e];
        const float rq = rsqrtf(wave_sum(ss) * (1.f / 384) + EPS);
        GAS unsigned* oq = (GAS unsigned*)(CQN + (size_t)row * 384 + lane * 6);
        oq[0] = pk2(q[0] * rq * gq[0], q[1] * rq * gq[1]); oq[1] = pk2(q[2] * rq * gq[2], q[3] * rq * gq[3]); oq[2] = pk2(q[4] * rq * gq[4], q[5] * rq * gq[5]);
        const u32x2 kw = *(GAS const u32x2*)(u + 384 + lane * 4);
        float kv[4] = {bflo(kw.x), bfhi(kw.x), bflo(kw.y), bfhi(kw.y)};
        float s2 = (kv[0] * kv[0] + kv[1] * kv[1]) + (kv[2] * kv[2] + kv[3] * kv[3]);
        const float rk = rsqrtf(wave_sum(s2) * (1.f / 256) + EPS);
        u32x2 ow; ow.x = pk2(kv[0] * rk * gk[0], kv[1] * rk * gk[1]); ow.y = pk2(kv[2] * rk * gk[2], kv[3] * rk * gk[3]);
        *(GAS u32x2*)(CKVN + (size_t)row * 256 + lane * 4) = ow;
        const float x = bf1(u + 640 + (lane & 31)); const float xp = swz_xor<16>(x);
        const float c = cs[t * 16 + (lane & 15)], s = sn[t * 16 + (lane & 15)];
        const float o = (lane & 16) ? (x * c + xp * s) : (x * c - xp * s);
        const bf16_t ob = tobf(o);
        if (lane < 32) {
            const int b_ = row / TT; bf16_t* kp = K + ((size_t)(b_ * 16) * TT + t) * 96 + 64 + lane;
#pragma unroll
            for (int h = 0; h < 16; ++h) kp[(size_t)h * TT * 96] = ob;
        }
    }
}

constexpr int KPITCH = 208, VPITCH = 144, KBUF = 64 * KPITCH, VBUF = 64 * VPITCH;
DI f32x16 mfma32(bf16x8 a, bf16x8 b, f32x16 c) { return __builtin_amdgcn_mfma_f32_32x32x16_bf16(a, b, c, 0, 0, 0); }
template <int VAR> DI void phase_attn(LAS unsigned char* lds, const bf16_t* Q, const bf16_t* K, const bf16_t* VT, bf16_t* O) {
    const int tid = otid(), lane = tid & 63, r32 = lane & 31, hi = lane >> 5; const int wid = __builtin_amdgcn_readfirstlane(tid >> 6);
    LAS unsigned char* kbuf = lds; LAS unsigned char* vbuf = lds + 2 * KBUF;
    const int krow0 = tid / 12, kch0 = tid % 12; const int id1 = tid + 512; const int krow1 = id1 / 12, kch1 = id1 % 12; const bool k2 = id1 < 768;
    const int vd = tid >> 3, vch = tid & 7;
    const int bid_ = obid(); const bool latin = (gridDim.x == 256);
    const int nsteps = latin ? 17 : (17 * 256 - bid_ + (int)gridDim.x - 1) / (int)gridDim.x;
    for (int st = 0; st < nsteps; ++st) {
        int qb, bh;
        if (latin) { const int x = bid_ & 7, li = bid_ >> 3, g = li >> 4, i = li & 15; const int base = x * 32 + g * 16;
            if (st < 16) { bh = base + st; qb = (i + st) % 17; } else { bh = base + i; qb = (i + 16) % 17; } }
        else { const int u = bid_ + st * (int)gridDim.x; qb = 16 - (u >> 8); bh = u & 255; }
        const int b = bh >> 4, h = bh & 15; const int q0 = qb * 256;
        const size_t rowb = (size_t)b * TT;
        const int qlast = (q0 + 255 < TT - 1) ? q0 + 255 : TT - 1; const int ntiles = (qlast >> 6) + 1;
        const int qw0 = q0 + 32 * wid; const bool wvalid = qw0 < TT;
        int my_last = (qw0 + 31) >> 6; if (my_last > ntiles - 1) my_last = ntiles - 1; if (!wvalid) my_last = -1;
        int tq = qw0 + r32; if (tq > TT - 1) tq = TT - 1;
        bf16x8 qr[6];
        { const bf16_t* qp = Q + (rowb + tq) * 1536 + h * 96 + 8 * hi;
#pragma unroll
          for (int s = 0; s < 6; ++s) qr[s] = *(GAS const bf16x8*)(qp + 16 * s); }
        const bf16_t* Kh = K + (size_t)bh * TT * 96; const bf16_t* Vh = VT + (size_t)(bh * 64 + vd) * 4160;
        u32x4 kr0, kr1 = {0u, 0u, 0u, 0u}, vr;
#define ATT_LOAD(j) do { int ra = 64 * (j) + krow0; if (ra > TT - 1) ra = TT - 1; kr0 = *(GAS const u32x4*)(Kh + (size_t)ra * 96 + kch0 * 8); \
            if (k2) { int rb = 64 * (j) + krow1; if (rb > TT - 1) rb = TT - 1; kr1 = *(GAS const u32x4*)(Kh + (size_t)rb * 96 + kch1 * 8); } \
            vr = *(GAS const u32x4*)(Vh + 64 * (j) + vch * 8); } while (0)
#define ATT_STORE(bufi) do { *(LAS u32x4*)(kbuf + (bufi) * KBUF + krow0 * KPITCH + kch0 * 16) = kr0; if (k2) *(LAS u32x4*)(kbuf + (bufi) * KBUF + krow1 * KPITCH + kch1 * 16) = kr1; \
            { LAS unsigned char* vp_ = vbuf + (bufi) * VBUF + vd * VPITCH + (vch >> 1) * 32 + (vch & 1) * 8; u32x2 lo_ = {vr.x, vr.y}, hi_ = {vr.z, vr.w}; *(LAS u32x2*)vp_ = lo_; *(LAS u32x2*)(vp_ + 16) = hi_; } } while (0)
        ATT_LOAD(0); ATT_STORE(0);
        __syncthreads();
        float mrun = 0.f, lrun = 0.f; f32x16 o0, o1;
#pragma unroll
        for (int r = 0; r < 16; ++r) { o0[r] = 0.f; o1[r] = 0.f; }
        for (int j = 0; j < ntiles; ++j) {
            const int buf = j & 1;
            if (VAR != 3 && j + 1 < ntiles) ATT_LOAD(j + 1);
            if (VAR != 4 && j <= my_last) {
                LAS const unsigned char* kb = kbuf + buf * KBUF + r32 * KPITCH + 16 * hi; LAS const unsigned char* vb = vbuf + buf * VBUF + r32 * VPITCH + 16 * hi;
                f32x16 p0, p1;
#pragma unroll
                for (int r = 0; r < 16; ++r) { p0[r] = -mrun; p1[r] = -mrun; }
                bf16x8 ka[12], va[8];
#pragma unroll
                for (int s = 0; s < 6; ++s) { ka[2 * s] = *(LAS const bf16x8*)(kb + 32 * s); ka[2 * s + 1] = *(LAS const bf16x8*)(kb + 32 * KPITCH + 32 * s); }
#pragma unroll
                for (int f = 0; f < 4; ++f) { va[2 * f] = *(LAS const bf16x8*)(vb + 32 * f); va[2 * f + 1] = *(LAS const bf16x8*)(vb + 32 * VPITCH + 32 * f); }
                __builtin_amdgcn_sched_barrier(0);
#pragma unroll
                for (int s = 0; s < 6; ++s) { if (VAR == 2) { p0[s] += __builtin_bit_cast(f32x4, ka[2 * s])[0]; p1[s] += __builtin_bit_cast(f32x4, ka[2 * s + 1])[1]; } else { p0 = mfma32(ka[2 * s], qr[s], p0); p1 = mfma32(ka[2 * s + 1], qr[s], p1); } }
                if (64 * j + 63 > qw0) {
                    const int qa = qw0 + r32, kb0 = 64 * j + 4 * hi;
#pragma unroll
                    for (int r = 0; r < 16; ++r) { const int kv = kb0 + (r & 3) + 8 * (r >> 2); if (kv > qa) p0[r] = -INFINITY; if (kv + 32 > qa) p1[r] = -INFINITY; }
                }
                float mx;
                { float a_ = __builtin_fmaxf(__builtin_fmaxf(p0[0], p0[1]), p1[0]), b_ = __builtin_fmaxf(__builtin_fmaxf(p0[2], p0[3]), p1[1]); a_ = __builtin_fmaxf(__builtin_fmaxf(a_, p1[2]), p1[3]);
#pragma unroll
                  for (int r = 4; r < 16; r += 4) { a_ = __builtin_fmaxf(__builtin_fmaxf(a_, p0[r]), p0[r + 1]); b_ = __builtin_fmaxf(__builtin_fmaxf(b_, p0[r + 2]), p0[r + 3]);
                      a_ = __builtin_fmaxf(__builtin_fmaxf(a_, p1[r]), p1[r + 1]); b_ = __builtin_fmaxf(__builtin_fmaxf(b_, p1[r + 2]), p1[r + 3]); }
                  mx = half_max(__builtin_fmaxf(a_, b_)); }
                if (j == 0) {
                    mrun = mx;
#pragma unroll
                    for (int r = 0; r < 16; ++r) { p0[r] -= mx; p1[r] -= mx; }
                } else if (__any(mx > 0.f)) {
                    const float dl = __builtin_fmaxf(mx, 0.f); mrun += dl; const float fsc = __builtin_amdgcn_exp2f(-dl); lrun *= fsc;
#pragma unroll
                    for (int r = 0; r < 16; ++r) { p0[r] -= dl; p1[r] -= dl; o0[r] *= fsc; o1[r] *= fsc; }
                }
                float ls = 0.f;
#pragma unroll
                for (int r = 0; r < 16; ++r) { if (VAR != 1) { p0[r] = __builtin_amdgcn_exp2f(p0[r]); p1[r] = __builtin_amdgcn_exp2f(p1[r]); } }
#pragma unroll
                for (int r = 0; r < 16; r += 2) ls += (p0[r] + p0[r + 1]) + (p1[r] + p1[r + 1]);
                lrun += ls;
                bf16x8 pf[4];
                { u32x4 w;
                  w.x = pk2(p0[0], p0[1]); w.y = pk2(p0[2], p0[3]); w.z = pk2(p0[4], p0[5]); w.w = pk2(p0[6], p0[7]); pf[0] = __builtin_bit_cast(bf16x8, w);
                  w.x = pk2(p0[8], p0[9]); w.y = pk2(p0[10], p0[11]); w.z = pk2(p0[12], p0[13]); w.w = pk2(p0[14], p0[15]); pf[1] = __builtin_bit_cast(bf16x8, w);
                  w.x = pk2(p1[0], p1[1]); w.y = pk2(p1[2], p1[3]); w.z = pk2(p1[4], p1[5]); w.w = pk2(p1[6], p1[7]); pf[2] = __builtin_bit_cast(bf16x8, w);
                  w.x = pk2(p1[8], p1[9]); w.y = pk2(p1[10], p1[11]); w.z = pk2(p1[12], p1[13]); w.w = pk2(p1[14], p1[15]); pf[3] = __builtin_bit_cast(bf16x8, w); }
#pragma unroll
                for (int f = 0; f < 4; ++f) { if (VAR == 2) { o0[f] += __builtin_bit_cast(f32x4, va[2 * f])[0] * __builtin_bit_cast(f32x4, pf[f])[1]; o1[f] += __builtin_bit_cast(f32x4, va[2 * f + 1])[2]; } else { o0 = mfma32(va[2 * f], pf[f], o0); o1 = mfma32(va[2 * f + 1], pf[f], o1); } }
            }
            if (VAR != 3 && j + 1 < ntiles) ATT_STORE(buf ^ 1);
            __syncthreads();
        }
        const float lt = half_sum(lrun);
        if (qw0 + r32 < TT) {
            const float inv = 1.f / lt; bf16_t* op = O + (rowb + qw0 + r32) * 1024 + h * 64 + 4 * hi;
#pragma unroll
            for (int g = 0; g < 4; ++g) {
                u32x2 w; w.x = pk2(o0[4 * g] * inv, o0[4 * g + 1] * inv); w.y = pk2(o0[4 * g + 2] * inv, o0[4 * g + 3] * inv); *(GAS u32x2*)(op + 8 * g) = w;
                w.x = pk2(o1[4 * g] * inv, o1[4 * g + 1] * inv); w.y = pk2(o1[4 * g + 2] * inv, o1[4 * g + 3] * inv); *(GAS u32x2*)(op + 32 + 8 * g) = w;
            }
        }
    }
#undef ATT_LOAD
#undef ATT_STORE
}

DI void phase_tailfin(bf16_t* HB, const float* T, int nsl, float* ss, LAS float* sl) {
    const int tid = otid(), lane = tid & 63, wid = tid >> 6;
    for (int r = obid(); r < 256; r += gridDim.x) {
        const size_t row = 65536 + r; GAS unsigned* hp = (GAS unsigned*)(HB + row * 1024) + tid; GAS const f32x2v* tp = (GAS const f32x2v*)(T + (size_t)r * 1024) + tid;
        const unsigned h = *hp; float v0 = bflo(h), v1 = bfhi(h);
        float t0 = 0.f, t1 = 0.f;
        for (int s = 0; s < nsl; ++s) { const f32x2v t = tp[(size_t)s * (256 * 512)]; t0 += t[0]; t1 += t[1]; }
        v0 += t0; v1 += t1;
        *hp = pk2(v0, v1);
        const float sq = wave_sum(v0 * v0 + v1 * v1);
        __syncthreads();
        if (lane == 0) sl[wid] = sq;
        __syncthreads();
        if (tid < 16) { float tot = 0.f; if (tid == 0) { for (int w = 0; w < 8; ++w) tot += sl[w]; } *(GAS float*)(ss + row * 16 + tid) = tot; }
    }
    __syncthreads();
}

DI void phase_infin(const float* T, int nsl, int N, bf16_t* O, int ldc, bf16_t* O2, int ld2, int split, const float* ss) {
    const int tid = otid();
    for (int r = obid(); r < 256; r += gridDim.x) {
        const size_t row = 65536 + r; GAS const f32x4* sp = (GAS const f32x4*)(ss + row * 16); const f32x4 a = sp[0], b = sp[1], c = sp[2], d = sp[3];
        const float s = ((a[0] + a[1]) + (a[2] + a[3])) + ((b[0] + b[1]) + (b[2] + b[3])) + ((c[0] + c[1]) + (c[2] + c[3])) + ((d[0] + d[1]) + (d[2] + d[3]));
        const float rstd = rsqrtf(s * (1.f / 1024) + 1e-6f);
        for (int c2 = 2 * tid; c2 < N; c2 += 1024) {
            GAS const f32x2v* tp = (GAS const f32x2v*)(T + (size_t)r * N + c2); float t0 = 0.f, t1 = 0.f;
            for (int k = 0; k < nsl; ++k) { const f32x2v t = *(GAS const f32x2v*)((GAS const float*)tp + (size_t)k * 256 * N); t0 += t[0]; t1 += t[1]; }
            bf16_t* dst = (c2 < split) ? O + row * ldc + c2 : O2 + row * ld2 + (c2 - split);
            *(GAS unsigned*)dst = pk2(t0 * rstd, t1 * rstd);
        }
    }
}

constexpr int N_PHASES = 1 + 2 * 11 + 2 * 12 + 1;
#ifndef PG8_SP2_FLAG
#define PG8_SP2_FLAG true
#endif
#ifndef PROBE_MASK
#define PROBE_MASK 0
#endif
constexpr size_t WS_BAR = 96 * MiB;
DI void grid_bar(unsigned* w) {
    asm volatile("s_waitcnt vmcnt(0)" ::: "memory");
    __syncthreads();
    if (threadIdx.x == 0) {
        __builtin_amdgcn_fence(__ATOMIC_RELEASE, "agent");
        asm volatile("s_waitcnt vmcnt(0)" ::: "memory");
        const unsigned g = blockIdx.x & 7u, ng = gridDim.x >> 3, lg = 31u - (unsigned)__builtin_clz(ng);
        const unsigned old = __hip_atomic_fetch_add(w + 64 * g, 1u, __ATOMIC_RELAXED, __HIP_MEMORY_SCOPE_AGENT);
        const unsigned gen = old >> lg;
        if ((old & (ng - 1u)) == ng - 1u) {
            const unsigned o2 = __hip_atomic_fetch_add(w + 64 * 16, 1u, __ATOMIC_RELAXED, __HIP_MEMORY_SCOPE_AGENT);
            if ((o2 & 7u) == 7u) {
#pragma unroll
                for (int j = 0; j < 8; ++j) (void)__hip_atomic_fetch_add(w + 64 * (8 + j), 1u, __ATOMIC_RELAXED, __HIP_MEMORY_SCOPE_AGENT);
            }
        }
        while (__hip_atomic_load(w + 64 * (8 + g), __ATOMIC_RELAXED, __HIP_MEMORY_SCOPE_AGENT) <= gen) __builtin_amdgcn_s_sleep(1);
        __builtin_amdgcn_fence(__ATOMIC_ACQUIRE, "agent");
        asm volatile("s_waitcnt vmcnt(0)" ::: "memory");
    }
    __syncthreads();
}
DI int probe_reps(int ph) {
    if (PROBE_MASK == 0) return 1;
    if (ph == 0 || ph == N_PHASES - 1) return ((PROBE_MASK >> 12) & 1) ? 2 : 1;
    int layer = 0, r = ph - 1;
    if (r >= 34) { layer = 3; r -= 34; } else if (r >= 23) { layer = 2; r -= 23; } else if (r >= 11) { layer = 1; r -= 11; }
    const int nmix = (layer & 1) ? 9 : 8; int kind = 0;
    if (r < nmix) { if ((layer & 1) == 0) { const int k[8] = {9, 15, 2, 10, 3, 4, 0, 14}; kind = k[r]; } else { const int k[9] = {9, 15, 5, 11, 11, 11, 6, 0, 14}; kind = k[r]; } }
    else { r -= nmix; kind = (r == 0) ? 8 : (r == 1) ? 0 : 14; }
#ifdef PROBE_RESID
    if (kind == 0 && ph != 0 && ph != N_PHASES - 1) { int l2 = 0, r2 = ph - 1; if (r2 >= 25) { l2 = 3; r2 -= 25; } else if (r2 >= 17) { l2 = 2; r2 -= 17; } else if (r2 >= 8) { l2 = 1; r2 -= 8; } const int nm2 = (l2 & 1) ? 7 : 6; if (r2 == nm2 - 1 || r2 == nm2 + 1) return 2; }
#endif
    if (((PROBE_MASK >> 13) & 1) && (kind == 8 || kind == 9 || kind == 10 || kind == 11 || kind == 0)) return 2;
    return ((PROBE_MASK >> kind) & 1) ? 2 : 1;
}
__global__ void __launch_bounds__(512, 2) mega(Params Pkarg) {
    extern __shared__ __attribute__((aligned(16))) unsigned char smem[];
    cg::grid_group grid = cg::this_grid();
    LAS unsigned char* lds = (LAS unsigned char*)smem;
    const int lo = Pkarg.ph_lo, hi = Pkarg.ph_hi;
    unsigned* barw = (unsigned*)(Pkarg.ws + WS_BAR);
    if (blockIdx.x == 0 && threadIdx.x < 17) __hip_atomic_store(barw + 64 * threadIdx.x, 0u, __ATOMIC_RELAXED, __HIP_MEMORY_SCOPE_AGENT);
    for (int ph = lo; ph < hi; ++ph) {
        int kz = 0; asm volatile("" : "+s"(kz));
        KParams P = (KParams)((const __attribute__((address_space(4))) char*)__builtin_amdgcn_kernarg_segment_ptr() + kz);
        unsigned char* ws = P->ws; unsigned char* dob = (unsigned char*)P->out;
        asm volatile("" : "+s"(ws), "+s"(dob));
        const float* cs = (const float*)(ws + WS_COS); const float* sn = (const float*)(ws + WS_SIN);
        unsigned char* R = ws + WS_R;
        bool do_sync = true;
        for (int rep = probe_reps(ph); rep > 0; --rep) {
        int layer = 0, r = ph - 1;
        if (ph == 0) { phase_prologue(P, (float*)smem); }
        else if (ph == N_PHASES - 1) { phase_final((const bf16_t*)(ws + WS_HB), P->in[25], P->out); }
        else {
            if (r >= 34) { layer = 3; r -= 34; } else if (r >= 23) { layer = 2; r -= 23; } else if (r >= 11) { layer = 1; r -= 11; }
            const int j = layer >> 1; const int nmix = (layer & 1) ? 9 : 8;
            int gk = -1; const bf16_t* gA = nullptr; const void* gB = nullptr; int gM = 0, gN = 0, gK = 0, gld = 0; size_t gAt = 0, gBt = 0, gApn = 0;
            pg8::EpiAny E{}; E.i2 = 1 << 30;
            bf16_t* HB = (bf16_t*)(ws + WS_HB); float* SS0 = (float*)(ws + WS_SS); float* SS1 = SS0; float* tf_ss = nullptr; int tf_n = 0;
            bf16_t* U1 = (bf16_t*)(R + R_U1); bf16_t* GATE = (bf16_t*)(R + R_GATE); bf16_t* XC = (bf16_t*)(R + R_XC); bf16_t* Y = (bf16_t*)(R + R_Y);
            bf16_t* A = (bf16_t*)(R + R_A); bf16_t* UU = (bf16_t*)(R + R_UU); float* agg = (float*)(ws + WS_AGG);
            bf16_t* U2 = (bf16_t*)(R + R_U2); bf16_t* CQN = (bf16_t*)(dob + DO_CQN); bf16_t* CKVN = (bf16_t*)(dob + DO_CKVN);
            bf16_t* Qb = (bf16_t*)(R + R_Q); bf16_t* Kb = (bf16_t*)(R + R_K); bf16_t* VT = (bf16_t*)(R + R_VT); bf16_t* Ob = (bf16_t*)(R + R_O);
            bf16_t* Gb = (bf16_t*)(R + R_G);
            if (r < nmix) {
                if ((layer & 1) == 0) {
                    if (r == 0) { gk = 0; gA = HB; gB = ws + WS_EVIN + j * SZ_EVIN; gM = M; gN = 2560; gK = 1024; E.p0 = U1; E.i0 = 2048; E.p1 = GATE; E.i1 = 512; E.i2 = 2048; E.f2 = SS0; }
                    else if (r == 1) phase_infin((const float*)(dob + DO_T), 8, 2560, U1, 2048, GATE, 512, 2048, SS0);
                    else if (r == 2) phase_evconv(U1, P->in[4] + j * 3 * 512, P->in[5] + j * 4 * 512, P->in[6] + j * 512, Y, XC);
                    else if (r == 3) { gk = 3; gA = XC; gB = ws + WS_EVG + j * SZ_EVG; gM = M; gN = 1024; gK = 128; gld = 512; gApn = 256; gBt = (size_t)512 * 512 + 256;
                                       E.p0 = A; E.p1 = XC; E.p2 = UU; E.f0 = P->in[8] + j * 512; E.f1 = P->in[10] + j * 512; E.f2 = P->in[11] + j * 512; }
                    else if (r == 4) phase_scan1(A, UU, agg);
                    else if (r == 5) phase_scan2(A, UU, agg, GATE, Y);
                    else if (r == 6) { gk = 2; gA = Y; gB = ws + WS_EVOUT + j * SZ_EVOUT; gM = M; gN = 1024; gK = 1024; E.i0 = 1024; E.p1 = HB; E.p2 = SS1; }
                    else { tf_ss = SS1; tf_n = 8; }
                } else {
                    if (r == 0) { gk = 0; gA = HB; gB = ws + WS_ODIN + j * SZ_ODIN; gM = M; gN = 768; gK = 1024; E.p0 = U2; E.i0 = 768; E.p1 = U2; E.i1 = 768; E.f2 = SS0; }
                    else if (r == 1) phase_infin((const float*)(dob + DO_T), 8, 768, U2, 768, U2, 768, 1 << 30, SS0);
                    else if (r == 2) phase_oddnorm(U2, P->in[15] + j * 384, P->in[16] + j * 256, cs, sn, CQN, CKVN, Kb);
                    else if (r == 3) { gk = 4; gA = CQN; gB = ws + WS_UQ + j * SZ_UQ; gM = M; gN = 1536; gK = 384; E.p0 = Qb; E.f0 = cs; E.f1 = sn; E.scale = 0.14724444f; do_sync = false; }
                    else if (r == 4) { gk = 1; gA = CKVN; gB = ws + WS_UK + j * SZ_UK; gM = M; gN = 1024; gK = 256; E.p0 = Kb; E.i0 = 1536; do_sync = false; }
                    else if (r == 5) { gk = 6; gA = (const bf16_t*)(ws + WS_UV + j * SZ_UK); gB = CKVN; gM = 1024; gN = M; gK = 256; E.p0 = VT; E.i0 = 4160; }
                    else if (r == 6) {
#ifdef ATT_VAR
                        if (rep == 1) phase_attn<ATT_VAR>(lds, Qb, Kb, VT, (bf16_t*)dob); else
#endif
                        phase_attn<0>(lds, Qb, Kb, VT, Ob); }
                    else if (r == 7) { gk = 2; gA = Ob; gB = ws + WS_ODOUT + j * SZ_ODOUT; gM = M; gN = 1024; gK = 1024; E.i0 = 1024; E.p1 = HB; E.p2 = SS1; }
                    else { tf_ss = SS1; tf_n = 8; }
                }
            } else {
                r -= nmix;
                if (r == 0) { gk = 5; gA = HB - 2 * 1024; gB = ws + WS_UP + layer * SZ_UP; gM = 260 * 256; gN = 5632; gK = 1024; gAt = (size_t)254 * 1024 * 2;
                              E.p0 = Gb; E.f0 = P->in[22] + (size_t)layer * 3 * 5632; E.f1 = P->in[23] + (size_t)layer * 5632; E.i0 = M; E.halo = (LAS float*)(lds + 131072); E.f2 = SS1; }
                else if (r == 1) { gk = 2; gA = Gb; gB = ws + WS_DOWN + layer * SZ_DOWN; gM = M; gN = 1024; gK = 2816; E.i0 = 1024; E.p1 = HB; E.p2 = SS0; }
                else { tf_ss = SS0; tf_n = 22; }
            }
            if (tf_ss) phase_tailfin(HB, (const float*)(dob + DO_T), tf_n, tf_ss, (LAS float*)lds);
            if (gk >= 0) {
                E.kind = gk;
#ifdef PROBE_RESID
                if (gk == 2 && rep == 1 && probe_reps(ph) == 2) { E.p1 = dob; E.p2 = dob + 160 * MiB; }
#endif
#if ((PROBE_MASK >> 13) & 1) || defined(PROBE_NOEPI)
                if (rep == 1 && probe_reps(ph) == 2) { E.kind = 7; E.p0 = dob; }
#endif
                const int ld = gld ? gld : gK;
                const int npass = (gk == 2 || (gk == 0 && E.f2 != nullptr)) ? 2 : 1;
                for (int pass = 0; pass < npass; ++pass) {
                    pg8::Gemm g{gA, (const bf16_t*)gB, gM, gN, gK, ld, ld, gAt ? gAt : (size_t)512 * ld, gBt ? gBt : (size_t)512 * ld, gApn, 0};
                    if (npass == 2) {
                        if (pass == 0) g.M = 65536;
                        else { g.A = gA + (size_t)65536 * ld; g.M = (gK / 128) * 256; g.K = 128; g.atstep = 256; g.b_pm = 256; E.kind = 8; E.p0 = dob + DO_T; E.i0 = gN; }
                    }
                    pg8::StaticOrder S; S.init(g.M, g.N, (int)gridDim.x, (int)blockIdx.x);
                    pg8::gemm_phase<pg8::EpiAny, pg8::StaticOrder, true, PG8_SP2_FLAG>(lds, g, S, E);
                }
            }
        }
        }
#ifdef IDLE_PROBE
        if (ph == 5 || ph == 20) for (int i = 0; i < 128; ++i) __builtin_amdgcn_s_sleep(127);
#endif
        if (do_sync && ph + 1 < hi) { if (ph == lo) grid.sync(); else grid_bar(barw); }
    }
}

#ifndef MULTI_LAUNCH
#define MULTI_LAUNCH 0
#endif
extern "C" void kernel_launch(void* const* d_in, const int* in_sizes, int n_in, void* d_out, int out_size, void* d_ws, size_t ws_size, hipStream_t stream) {
    static int grid = 0;
    if (grid == 0) {
        if (n_in != 26 || ws_size < WS_NEED || out_size != NB * SEQ * DM) { fprintf(stderr, "kernel_launch: unexpected problem (n_in %d, ws %zu, out %d)\n", n_in, ws_size, out_size); grid = -1; return; }
        int dev = 0, cus = 0, per_cu = 0;
        hipGetDevice(&dev); hipDeviceGetAttribute(&cus, hipDeviceAttributeMultiprocessorCount, dev);
        if (hipFuncSetAttribute((const void*)mega, hipFuncAttributeMaxDynamicSharedMemorySize, LDS_BYTES) != hipSuccess) { fprintf(stderr, "kernel_launch: hipFuncSetAttribute failed\n"); grid = -1; return; }
        if (hipOccupancyMaxActiveBlocksPerMultiprocessor(&per_cu, (const void*)mega, 512, LDS_BYTES) != hipSuccess || per_cu < 1) { fprintf(stderr, "kernel_launch: occupancy query failed (%d)\n", per_cu); per_cu = 1; }
        (void)hipGetLastError();
        grid = 1; while (grid * 2 <= cus * per_cu) grid *= 2;
        fprintf(stderr, "kernel_launch: grid %d (cus %d x %d)\n", grid, cus, per_cu);
    }
    if (grid < 0) return;
    Params p{};
    for (int i = 0; i < 26; ++i) p.in[i] = (const float*)d_in[i];
    p.out = (float*)d_out; p.ws = (unsigned char*)d_ws;
#if MULTI_LAUNCH
    for (int i = 0; i < N_PHASES; ++i) { p.ph_lo = i; p.ph_hi = i + 1; hipLaunchKernelGGL(mega, dim3(grid), dim3(512), LDS_BYTES, stream, p); }
#else
    p.ph_lo = 0; p.ph_hi = N_PHASES;
    void* args[] = {&p};
    hipError_t e = hipLaunchCooperativeKernel((const void*)mega, dim3(grid), dim3(512), args, LDS_BYTES, stream);
    if (e != hipSuccess) fprintf(stderr, "cooperative launch failed: %s (grid %d)\n", hipGetErrorString(e), grid);
#endif
}
```

```cpp
#include <hip/hip_runtime.h>
#include <hip/hip_cooperative_groups.h>
#include <cstdio>
#include <cstdint>
namespace cg = cooperative_groups;
namespace pg8 {
#define PG8_LAS __attribute__((address_space(3)))
typedef unsigned short bf16_t;
typedef short bf16x8 __attribute__((ext_vector_type(8)));
typedef float f32x4 __attribute__((ext_vector_type(4)));
typedef unsigned u32x4 __attribute__((ext_vector_type(4)));
constexpr int BM = 256, BK = 64, HALF = 128, HTB = HALF * BK * 2  , STAGE_BYTES = 8 * HTB, NXCD = 8, WGM = 8;

__host__ __device__ __forceinline__ int lds_byte(int r, int c) { const int st = (r >> 4) * 2 + (c >> 5), rr = r & 15, cc = c & 31, ob = rr * 64 + cc * 2; return st * 1024 + (ob ^ (((ob >> 9) & 1) << 5)); }
__host__ __device__ __forceinline__ void stage_rc(int b, int& R, int& C) { const int st = b / 1024, sb = b % 1024, swz = sb ^ (((sb >> 9) & 1) << 5); R = (st >> 1) * 16 + swz / 64; C = (st & 1) * 32 + (swz % 64) / 2; }
__host__ __device__ __forceinline__ int perm32(int rho) { const int n = rho >> 4, i = rho & 15; return 8 * (i >> 2) + 4 * n + (i & 3); }

struct Unit { int pm, pn; };
struct Gemm { const bf16_t* A; const bf16_t* Bt; int M, N, K; int lda, ldb; size_t atstep, btstep, a_pn, b_pm; };

struct StaticOrder {
    int nM, nN, nwg, G, c;
    __host__ __device__ void init(int M, int N, int G_, int c_) { nM = M / BM; nN = N / BM; nwg = nM * nN; G = G_; c = c_; }
    __host__ __device__ bool next(int i, Unit& u) const {
        const long L = (long)i * G + c; if (L >= nwg) return false;
        int wgid = (int)L; { const int q = nwg / NXCD, r = nwg % NXCD, xcd = wgid % NXCD, off = wgid / NXCD; wgid = (xcd < r ? xcd * (q + 1) : r * (q + 1) + (xcd - r) * q) + off; }
        const int nig = WGM * nN, gid = wgid / nig, fm = gid * WGM, gsz = (nM - fm) < WGM ? (nM - fm) : WGM;
        u.pm = fm + ((wgid % nig) % gsz); u.pn = (wgid % nig) / gsz; return true;
    }
    __device__ __forceinline__ void a_ready(const Unit&) const {}
    __device__ __forceinline__ void done(const Unit&) const {}
};

__device__ __forceinline__ unsigned cvt_pk_bf16(float lo, float hi) { unsigned r; asm volatile("v_cvt_pk_bf16_f32 %0, %1, %2" : "=v"(r) : "v"(lo), "v"(hi)); return r; }
#define GAS __attribute__((address_space(1)))
typedef unsigned u32x2 __attribute__((ext_vector_type(2)));
typedef float f32x2v __attribute__((ext_vector_type(2)));
typedef __bf16 bf16x2v __attribute__((ext_vector_type(2)));
__device__ __forceinline__ unsigned pk2(float lo, float hi) { f32x2v v = {lo, hi}; bf16x2v b = __builtin_convertvector(v, bf16x2v); return __builtin_bit_cast(unsigned, b); }
constexpr int TT = 4112;

__device__ __forceinline__ float row_rstd(const float* ss, int row, int fq) {
    const f32x4 a = *(GAS const f32x4*)(ss + (size_t)row * 16 + 4 * fq);
    float s = (a[0] + a[1]) + (a[2] + a[3]);
    s += __int_as_float(__builtin_amdgcn_ds_swizzle(__float_as_int(s), (16 << 10) | 0x1f));
    { auto rr = __builtin_amdgcn_permlane32_swap(__float_as_uint(s), __float_as_uint(s), false, false); s = __uint_as_float(rr[0]) + __uint_as_float(rr[1]); }
    return rsqrtf(s * (1.f / 1024) + 1e-6f);
}
template <int MODE> struct EpiStore {
    static constexpr bool PERM = true, AFTER_DRAIN = false;
    bf16_t* O; int ldc; bf16_t* O2; int ld2; int split; const float* ss;
    __device__ __forceinline__ void operator()(const f32x4 (&acc)[2][2][4][2], const Unit& u, int wr, int wc, int fr, int fq) const {
        const int row0 = u.pm * BM + wr * 64 + fr; const int ct = u.pn * BM;
        bf16_t* base = O; int ld = ldc; int c0 = ct + wc * 32 + 8 * fq;
        if (ct >= split) { base = O2; ld = ld2; c0 -= split; }
#pragma unroll
        for (int ai = 0; ai < 2; ++ai)
#pragma unroll
            for (int m = 0; m < 4; ++m) { const int row = row0 + ai * HALF + m * 16; bf16_t* rp = base + (size_t)row * ld;
                float rs = 1.f; if (MODE == 0 && ss) rs = row_rstd(ss, row, fq);
#pragma unroll
                for (int bj = 0; bj < 2; ++bj) { int c = c0 + bj * HALF;
                    if (MODE == 1) { const int b_ = row / TT, t_ = row - b_ * TT; rp = base; c = (((b_ * 16 + (c >> 6)) * TT + t_) * 96) + (c & 63); }
                    if (MODE == 2) { const int b_ = c / TT, t_ = c - b_ * TT; rp = base + ((size_t)((b_ * 16 + (row >> 6)) * 64 + (row & 63))) * 4160; c = t_; }
                    const f32x4 v0 = acc[ai][bj][m][0] * rs, v1 = acc[ai][bj][m][1] * rs; u32x4 w; w.x = pk2(v0[0], v0[1]); w.y = pk2(v0[2], v0[3]); w.z = pk2(v1[0], v1[1]); w.w = pk2(v1[2], v1[3]);
                    *(GAS u32x4*)(rp + c) = w; } }
    }
};
struct EpiResid {
    static constexpr bool PERM = true, AFTER_DRAIN = false;
    bf16_t* HB; int ld; float* ss;
    __device__ __forceinline__ void operator()(const f32x4 (&acc)[2][2][4][2], const Unit& u, int wr, int wc, int fr, int fq) const {
        const int row0 = u.pm * BM + wr * 64 + fr; const int c0 = u.pn * BM + wc * 32 + 8 * fq;
#pragma unroll
        for (int ai = 0; ai < 2; ++ai)
#pragma unroll
            for (int m = 0; m < 4; ++m) { const int row = row0 + ai * HALF + m * 16; bf16_t* bp = HB + (size_t)row * ld + c0; float sq = 0.f;
#pragma unroll
                for (int bj = 0; bj < 2; ++bj) { GAS u32x4* p = (GAS u32x4*)(bp + bj * HALF); const u32x4 h = *p; const f32x4 a0 = acc[ai][bj][m][0], a1 = acc[ai][bj][m][1];
                    const float v0 = __uint_as_float(h.x << 16) + a0[0], v1 = __uint_as_float(h.x & 0xffff0000u) + a0[1], v2 = __uint_as_float(h.y << 16) + a0[2], v3 = __uint_as_float(h.y & 0xffff0000u) + a0[3];
                    const float v4 = __uint_as_float(h.z << 16) + a1[0], v5 = __uint_as_float(h.z & 0xffff0000u) + a1[1], v6 = __uint_as_float(h.w << 16) + a1[2], v7 = __uint_as_float(h.w & 0xffff0000u) + a1[3];
                    u32x4 w; w.x = pk2(v0, v1); w.y = pk2(v2, v3); w.z = pk2(v4, v5); w.w = pk2(v6, v7); *p = w;
                    sq += ((v0 * v0 + v1 * v1) + (v2 * v2 + v3 * v3)) + ((v4 * v4 + v5 * v5) + (v6 * v6 + v7 * v7)); }
                sq += __int_as_float(__builtin_amdgcn_ds_swizzle(__float_as_int(sq), (16 << 10) | 0x1f));
                { auto rr = __builtin_amdgcn_permlane32_swap(__float_as_uint(sq), __float_as_uint(sq), false, false); sq = __uint_as_float(rr[0]) + __uint_as_float(rr[1]); }
                if (fq == 0) ss[(size_t)row * 16 + u.pn * 4 + wc] = sq; }
    }
};
struct EpiGate {
    static constexpr bool PERM = true, AFTER_DRAIN = false;
    const bf16_t* XC; bf16_t* A; bf16_t* U; const float* rb; const float* ib; const float* lam;
    __device__ __forceinline__ void operator()(const f32x4 (&acc)[2][2][4][2], const Unit& u, int wr, int wc, int fr, int fq) const {
        const int row0 = u.pm * BM + wr * 64 + fr; const int ch0 = u.pn * 128 + wc * 32 + 8 * fq;
        f32x4 rb4[2], ib4[2], sp4[2];
#pragma unroll
        for (int n = 0; n < 2; ++n) { rb4[n] = *(GAS const f32x4*)(rb + ch0 + 4 * n); ib4[n] = *(GAS const f32x4*)(ib + ch0 + 4 * n); const f32x4 l4 = *(GAS const f32x4*)(lam + ch0 + 4 * n);
#pragma unroll
            for (int j = 0; j < 4; ++j) sp4[n][j] = -8.f * log1pf(expf(-l4[j])); }
#pragma unroll
        for (int ai = 0; ai < 2; ++ai)
#pragma unroll
            for (int m = 0; m < 4; ++m) { const size_t ro = (size_t)(row0 + ai * HALF + m * 16) * 512 + ch0; const u32x4 xw = *(GAS const u32x4*)(XC + ro);
                float xc[8]; xc[0] = __uint_as_float(xw.x << 16); xc[1] = __uint_as_float(xw.x & 0xffff0000u); xc[2] = __uint_as_float(xw.y << 16); xc[3] = __uint_as_float(xw.y & 0xffff0000u);
                xc[4] = __uint_as_float(xw.z << 16); xc[5] = __uint_as_float(xw.z & 0xffff0000u); xc[6] = __uint_as_float(xw.w << 16); xc[7] = __uint_as_float(xw.w & 0xffff0000u);
                float av[8], uv[8];
#pragma unroll
                for (int n = 0; n < 2; ++n) { const f32x4 rp = acc[ai][0][m][n] + rb4[n], ip = acc[ai][1][m][n] + ib4[n];
#pragma unroll
                    for (int j = 0; j < 4; ++j) { const float r = __builtin_amdgcn_rcpf(1.f + __expf(-rp[j])), ig = __builtin_amdgcn_rcpf(1.f + __expf(-ip[j])); const float la = r * sp4[n][j];
                        const float a = expf(la); av[4 * n + j] = la; uv[4 * n + j] = __builtin_amdgcn_sqrtf(fmaxf(1.f - a * a, 0.f)) * ig * xc[4 * n + j]; } }
                u32x4 wa, wu; wa.x = pk2(av[0], av[1]); wa.y = pk2(av[2], av[3]); wa.z = pk2(av[4], av[5]); wa.w = pk2(av[6], av[7]);
                wu.x = pk2(uv[0], uv[1]); wu.y = pk2(uv[2], uv[3]); wu.z = pk2(uv[4], uv[5]); wu.w = pk2(uv[6], uv[7]);
                *(GAS u32x4*)(A + ro) = wa; *(GAS u32x4*)(U + ro) = wu; }
    }
};
struct EpiQ {
    static constexpr bool PERM = true, AFTER_DRAIN = false;
    bf16_t* Q; const float* cs; const float* sn; float scale;
    __device__ __forceinline__ void operator()(const f32x4 (&acc)[2][2][4][2], const Unit& u, int wr, int wc, int fr, int fq) const {
        const int row0 = u.pm * BM + wr * 64 + fr; const int cb = u.pn * BM + wc * 32;
#pragma unroll
        for (int ai = 0; ai < 2; ++ai)
#pragma unroll
            for (int m = 0; m < 4; ++m) { const int row = row0 + ai * HALF + m * 16; const int t = row % TT; bf16_t* rp = Q + (size_t)row * 1536;
#pragma unroll
                for (int bj = 0; bj < 2; ++bj) { const int c = cb + bj * HALF; f32x4 v0 = acc[ai][bj][m][0], v1 = acc[ai][bj][m][1];
                    if (((c >> 5) % 3) == 2) {
                        const float* cp = cs + t * 16 + 8 * (fq & 1); const float* sp = sn + t * 16 + 8 * (fq & 1);
                        const f32x4 c0 = *(const f32x4*)cp, c1 = *(GAS const f32x4*)(cp + 4), s0 = *(const f32x4*)sp, s1 = *(GAS const f32x4*)(sp + 4);
                        f32x4 o0, o1; const bool upper = (fq >= 2);
#pragma unroll
                        for (int j = 0; j < 4; ++j) {
                            const float a = v0[j], b = v1[j];
                            auto ra = __builtin_amdgcn_permlane32_swap(__float_as_uint(a), __float_as_uint(a), false, false); auto rbb = __builtin_amdgcn_permlane32_swap(__float_as_uint(b), __float_as_uint(b), false, false);
                            const float pa = __uint_as_float(upper ? ra[0] : ra[1]), pb = __uint_as_float(upper ? rbb[0] : rbb[1]);
                            o0[j] = upper ? (a * c0[j] + pa * s0[j]) : (a * c0[j] - pa * s0[j]);
                            o1[j] = upper ? (b * c1[j] + pb * s1[j]) : (b * c1[j] - pb * s1[j]);
                        }
                        v0 = o0; v1 = o1;
                    }
                    v0 = v0 * scale; v1 = v1 * scale; u32x4 w; w.x = pk2(v0[0], v0[1]); w.y = pk2(v0[2], v0[3]); w.z = pk2(v1[0], v1[1]); w.w = pk2(v1[2], v1[3]);
                    *(GAS u32x4*)(rp + c + 8 * fq) = w; } }
    }
};

template <int CTRL> __device__ __forceinline__ f32x2v dpp_ror(f32x2v v) { f32x2v r; const float x0 = v[0], x1 = v[1];
    r[0] = __int_as_float(__builtin_amdgcn_mov_dpp(__float_as_int(x0), CTRL, 0xf, 0xf, true)); r[1] = __int_as_float(__builtin_amdgcn_mov_dpp(__float_as_int(x1), CTRL, 0xf, 0xf, true)); return r; }
struct EpiUp {
    static constexpr bool PERM = true, AFTER_DRAIN = false;
    bf16_t* G; const float* cw; const float* cb; PG8_LAS float* halo; int Mrows; const float* ss;
    __device__ __forceinline__ void operator()(const f32x4 (&acc)[2][2][4][2], const Unit& u, int wr, int wc, int fr, int fq) const {
        const int rb = u.pm * 254 - 2;
        float rs[2][4]; unsigned flags = 0;
#pragma unroll
        for (int ai = 0; ai < 2; ++ai)
#pragma unroll
            for (int m = 0; m < 4; ++m) { const int lrow = 128 * ai + 64 * wr + 16 * m + fr; const int row = rb + lrow; const int rc = row < 0 ? 0 : (row >= Mrows ? Mrows - 1 : row);
                rs[ai][m] = row_rstd(ss, rc, fq); const int t = rc % TT;
                const unsigned f = ((lrow >= 2 && row < Mrows) ? 1u : 0u) | ((t == 0) ? 2u : 0u) | ((t <= 1) ? 4u : 0u); flags |= f << (3 * (ai * 4 + m)); }
        {
            const int t2 = 2 * (((wr * 4 + wc) * 64) + fq * 16 + fr); const int k_ = t2 >> 8, bj_ = (t2 >> 7) & 1, cc_ = t2 & 127;
            const float* src_ = (k_ < 3 ? cw + k_ * 5632 : cb) + bj_ * 2816 + u.pn * 128 + cc_;
            *(PG8_LAS f32x2v*)(halo + 2048 + t2) = *(GAS const f32x2v*)src_; }
        if (fr >= 14) {
#pragma unroll
            for (int ai = 0; ai < 2; ++ai) { PG8_LAS float* hw = halo + ((((2 * ai + wr) * 2 + (fr - 14)) * 4 + wc) * 64) + fq * 4;
#pragma unroll
                for (int bj = 0; bj < 2; ++bj)
#pragma unroll
                    for (int n = 0; n < 2; ++n) *(PG8_LAS f32x4*)(hw + (bj * 2 + n) * 16) = acc[ai][bj][3][n] * rs[ai][3]; }
        }
        asm volatile("s_waitcnt lgkmcnt(0)\n\ts_barrier" ::: "memory");
        const bool bstart = __any((flags & 0xDB6DB6u) != 0u);
        const bool allemit = __all((flags & 0x249249u) == 0x249249u);
        const f32x2v zero = {0.f, 0.f};
#pragma unroll
        for (int nn = 0; nn < 4; ++nn) {
            const int n = nn >> 1, jh = nn & 1;
            const int ca0 = u.pn * 128 + wc * 32 + 8 * fq + 4 * n + 2 * jh;
            PG8_LAS const float* wl = halo + 2048 + wc * 32 + 8 * fq + 4 * n + 2 * jh;
            const f32x2v wA0 = *(PG8_LAS const f32x2v*)(wl), wA1 = *(PG8_LAS const f32x2v*)(wl + 256), wA2 = *(PG8_LAS const f32x2v*)(wl + 512), bA = *(PG8_LAS const f32x2v*)(wl + 768);
            const f32x2v wG0 = *(PG8_LAS const f32x2v*)(wl + 128), wG1 = *(PG8_LAS const f32x2v*)(wl + 256 + 128), wG2 = *(PG8_LAS const f32x2v*)(wl + 512 + 128), bG = *(PG8_LAS const f32x2v*)(wl + 768 + 128);
#pragma unroll
            for (int ai = 0; ai < 2; ++ai) {
                const int s = 2 * ai + wr;
                f32x2v cA1 = zero, cA2 = zero, cG1 = zero, cG2 = zero;
                if (s > 0) { PG8_LAS const float* hr = halo + ((((s - 1) * 2) * 4 + wc) * 64) + fq * 4 + n * 16 + 2 * jh;
                    const f32x2v a2 = *(PG8_LAS const f32x2v*)(hr), a1 = *(PG8_LAS const f32x2v*)(hr + 256), g2 = *(PG8_LAS const f32x2v*)(hr + 32), g1 = *(PG8_LAS const f32x2v*)(hr + 256 + 32);
                    cA1 = a1; cG1 = g1; cA2 = (fr == 0) ? a2 : a1; cG2 = (fr == 0) ? g2 : g1; }
#pragma unroll
                for (int m = 0; m < 4; ++m) {
                    const f32x4 ua4 = acc[ai][0][m][n], ug4 = acc[ai][1][m][n]; const float rsm = rs[ai][m];
                    const f32x2v ua = {ua4[2 * jh] * rsm, ua4[2 * jh + 1] * rsm}, ug = {ug4[2 * jh] * rsm, ug4[2 * jh + 1] * rsm};
                    const f32x2v rA1 = dpp_ror<0x121>(ua), rA2 = dpp_ror<0x122>(ua), rG1 = dpp_ror<0x121>(ug), rG2 = dpp_ror<0x122>(ug);
                    f32x2v pA1 = (fr >= 1) ? rA1 : cA1, pA2 = (fr >= 2) ? rA2 : cA2, pG1 = (fr >= 1) ? rG1 : cG1, pG2 = (fr >= 2) ? rG2 : cG2;
                    const int row = rb + 128 * ai + 64 * wr + 16 * m + fr; const unsigned f = flags >> (3 * (ai * 4 + m));
                    if (bstart) { if (f & 2u) { pA1 = zero; pG1 = zero; }
                                  if (f & 4u) { pA2 = zero; pG2 = zero; } }
                    const f32x2v va = wA0 * pA2 + wA1 * pA1 + wA2 * ua + bA, vg = wG0 * pG2 + wG1 * pG1 + wG2 * ug + bG;
                    const float o0 = va[0] * __builtin_amdgcn_rcpf(1.f + __expf(-va[0])) * vg[0], o1 = va[1] * __builtin_amdgcn_rcpf(1.f + __expf(-va[1])) * vg[1];
                    if (allemit) *(GAS unsigned*)(G + (size_t)row * 2816 + ca0) = pk2(o0, o1);
                    else if (f & 1u) *(GAS unsigned*)(G + (size_t)row * 2816 + ca0) = pk2(o0, o1);
                    cA1 = rA1; cA2 = rA2; cG1 = rG1; cG2 = rG2;
                }
            }
        }
    }
};
struct EpiAny {
    static constexpr bool PERM = true, AFTER_DRAIN = false;
    int kind; void* p0; void* p1; void* p2; const float* f0; const float* f1; const float* f2; int i0, i1, i2; float scale; PG8_LAS float* halo;
    __device__ __forceinline__ void operator()(const f32x4 (&acc)[2][2][4][2], const Unit& u, int wr, int wc, int fr, int fq) const {
        if (kind == 0) { EpiStore<0> e{(bf16_t*)p0, i0, (bf16_t*)p1, i1, i2, f2}; e(acc, u, wr, wc, fr, fq); }
        else if (kind == 1) { EpiStore<1> e{(bf16_t*)p0, i0, (bf16_t*)p0, i0, 1 << 30, nullptr}; e(acc, u, wr, wc, fr, fq); }
        else if (kind == 6) { EpiStore<2> e{(bf16_t*)p0, i0, (bf16_t*)p0, i0, 1 << 30, nullptr}; e(acc, u, wr, wc, fr, fq); }
        else if (kind == 2) { EpiResid e{(bf16_t*)p1, i0, (float*)p2}; e(acc, u, wr, wc, fr, fq); }
        else if (kind == 3) { EpiGate e{(const bf16_t*)p1, (bf16_t*)p0, (bf16_t*)p2, f0, f1, f2}; e(acc, u, wr, wc, fr, fq); }
        else if (kind == 4) { EpiQ e{(bf16_t*)p0, f0, f1, scale}; e(acc, u, wr, wc, fr, fq); }
        else if (kind == 5) { EpiUp e{(bf16_t*)p0, f0, f1, halo, i0, f2}; e(acc, u, wr, wc, fr, fq); }
        else if (kind == 8) {
            int rz = 0; asm volatile("" : "+v"(rz));
            float* T = (float*)p0 + (size_t)u.pm * (256 * 1024); const int c0 = u.pn * BM + wc * 32 + 8 * fq;
#pragma unroll
            for (int ai = 0; ai < 2; ++ai)
#pragma unroll
                for (int m = 0; m < 4; ++m) { float* rp = T + (size_t)(wr * 64 + fr + rz + ai * HALF + m * 16) * 1024 + c0;
#pragma unroll
                    for (int bj = 0; bj < 2; ++bj)
#pragma unroll
                        for (int n = 0; n < 2; ++n) *(GAS f32x4*)(rp + bj * HALF + 4 * n) = acc[ai][bj][m][n]; }
        }
        else { if (acc[0][0][0][0][0] == 123456.789f) *(float*)p0 = 1.f; }
    }
};
template <class Epi, class Sched, bool ALIGN_EPI = false, bool SP2 = false>
__device__ __forceinline__ void gemm_phase(PG8_LAS unsigned char* lds, const Gemm g, const Sched& S, const Epi& E) {
    int tid0 = threadIdx.x; asm volatile("" : "+v"(tid0));
    const int tid = tid0, wid = __builtin_amdgcn_readfirstlane(tid >> 6), lane = tid & 63, wr = wid >> 2, wc = wid & 3, fr = lane & 15, fq = lane >> 4;
    const int K = g.K, nt = K / BK;
    unsigned voffA[2], voffB[2];
#pragma unroll
    for (int i = 0; i < 2; ++i) { int R, C; stage_rc(tid * 16 + i * 8192, R, C); const int Rb = Epi::PERM ? ((R & ~31) + perm32(R & 31)) : R;
        voffA[i] = (unsigned)(R * g.lda + C) * 2u; voffB[i] = (unsigned)(Rb * g.ldb + C) * 2u; }
    const size_t kstep = (size_t)(BK * 2);
    const size_t hstepA = (size_t)HALF * g.lda * 2, hstepB = (size_t)HALF * g.ldb * 2;
    const unsigned ldsw = (unsigned)wid * 1024u;
    const int aoff = lds_byte(wr * 64 + fr, fq * 8), boff = lds_byte(wc * 32 + fr, fq * 8);
#define PG8_SA(b, h) (((b) * 2 + (h)) * HTB)
#define PG8_SB(b, h) ((4 + (b) * 2 + (h)) * HTB)
#define PG8_STAGE(bufoff, gbase, voff) do { _Pragma("unroll") for (int _i = 0; _i < 2; ++_i) \
        __builtin_amdgcn_global_load_lds((const unsigned*)((const char*)(gbase) + (voff)[_i]), (PG8_LAS unsigned*)(lds + (bufoff) + ldsw + _i * 8192), 16, 0, 0); } while (0)
#define PG8_LDA(dst, b, h) do { _Pragma("unroll") for (int m = 0; m < 4; ++m) _Pragma("unroll") for (int k = 0; k < 2; ++k) dst[m][k] = *(const PG8_LAS bf16x8*)(lds + PG8_SA(b, h) + aoff + m * 2048 + k * 1024); } while (0)
#define PG8_LDB(dst, b, h) do { _Pragma("unroll") for (int n = 0; n < 2; ++n) _Pragma("unroll") for (int k = 0; k < 2; ++k) dst[n][k] = *(const PG8_LAS bf16x8*)(lds + PG8_SB(b, h) + boff + n * 2048 + k * 1024); } while (0)
#define PG8_MMA(ai, bj, At, Bt) do { __builtin_amdgcn_s_setprio(1); _Pragma("unroll") for (int m = 0; m < 4; ++m) _Pragma("unroll") for (int n = 0; n < 2; ++n) _Pragma("unroll") for (int k = 0; k < 2; ++k) \
        acc[ai][bj][m][n] = __builtin_amdgcn_mfma_f32_16x16x32_bf16(Bt[n][k], At[m][k], acc[ai][bj][m][n], 0, 0, 0); __builtin_amdgcn_s_setprio(0); } while (0)
#define PG8_WAIT_V(n) asm volatile("s_waitcnt vmcnt(" #n ")" ::: "memory")
#define PG8_WAIT_L(n) asm volatile("s_waitcnt lgkmcnt(" #n ")" ::: "memory")
#define PG8_BAR __builtin_amdgcn_s_barrier()
#define PG8_SCHED __builtin_amdgcn_sched_barrier(0)
    Unit cur, nxt; int ui = 0;
    if (!S.next(0, cur)) return;
    f32x4 acc[2][2][4][2];
#pragma unroll
    for (int a = 0; a < 2; ++a)
#pragma unroll
        for (int b = 0; b < 2; ++b)
#pragma unroll
            for (int m = 0; m < 4; ++m)
#pragma unroll
                for (int n = 0; n < 2; ++n) acc[a][b][m][n] = (f32x4){0.f, 0.f, 0.f, 0.f};
    bf16x8 At[4][2], B0[2][2], B1[2][2];
    const char* cA = (const char*)g.A + (size_t)cur.pm * g.atstep + (size_t)cur.pn * g.a_pn; const char* cB = (const char*)g.Bt + (size_t)cur.pn * g.btstep + (size_t)cur.pm * g.b_pm;
    S.a_ready(cur);
    if constexpr (SP2) {
        PG8_STAGE(PG8_SB(0, 0), cB, voffB); PG8_STAGE(PG8_SB(0, 1), cB + hstepB, voffB); PG8_STAGE(PG8_SA(0, 0), cA, voffA); PG8_STAGE(PG8_SA(0, 1), cA + hstepA, voffA);
        if (wr == 1) PG8_BAR;
        PG8_WAIT_V(2); PG8_BAR;
        PG8_STAGE(PG8_SB(1, 0), cB + kstep, voffB); PG8_STAGE(PG8_SA(1, 0), cA + kstep, voffA); PG8_STAGE(PG8_SB(1, 1), cB + hstepB + kstep, voffB);
        PG8_WAIT_V(6); PG8_BAR;
    } else {
        PG8_STAGE(PG8_SB(0, 0), cB, voffB); PG8_STAGE(PG8_SA(0, 0), cA, voffA); PG8_STAGE(PG8_SB(0, 1), cB + hstepB, voffB); PG8_STAGE(PG8_SA(0, 1), cA + hstepA, voffA);
        if (wr == 1) PG8_BAR;
        PG8_WAIT_V(4); PG8_BAR;
        PG8_STAGE(PG8_SB(1, 0), cB + kstep, voffB); PG8_STAGE(PG8_SA(1, 0), cA + kstep, voffA); PG8_STAGE(PG8_SB(1, 1), cB + hstepB + kstep, voffB);
        PG8_WAIT_V(6); PG8_BAR;
    }
    for (;;) {
        const bool has_next = S.next(ui + 1, nxt);
        const char* nA = has_next ? (const char*)g.A + (size_t)nxt.pm * g.atstep + (size_t)nxt.pn * g.a_pn : cA; const char* nB = has_next ? (const char*)g.Bt + (size_t)nxt.pn * g.btstep + (size_t)nxt.pm * g.b_pm : cB;
        for (int t = 0; t < nt; t += 2) {
            const bool last = (t == nt - 2);
            const char* a1 = cA + (size_t)(t + 1) * kstep;
            const char* a2 = last ? nA : cA + (size_t)(t + 2) * kstep; const char* b2 = last ? nB : cB + (size_t)(t + 2) * kstep;
            const char* a3 = a2 + kstep; const char* b3 = b2 + kstep;
            if (last && has_next) S.a_ready(nxt);
            if constexpr (SP2) {
            PG8_LDB(B0, 0, 0); PG8_LDB(B1, 0, 1); PG8_SCHED; PG8_LDA(At, 0, 0); PG8_STAGE(PG8_SA(1, 1), a1 + hstepA, voffA);
            PG8_WAIT_V(8); PG8_WAIT_L(0); PG8_BAR; PG8_MMA(0, 0, At, B0); PG8_MMA(0, 1, At, B1); PG8_BAR; PG8_SCHED;
            PG8_LDA(At, 0, 1); PG8_STAGE(PG8_SB(0, 0), b2, voffB); PG8_STAGE(PG8_SB(0, 1), b2 + hstepB, voffB); PG8_STAGE(PG8_SA(0, 0), a2, voffA);
            PG8_WAIT_V(8); PG8_WAIT_L(0); PG8_BAR; PG8_MMA(1, 0, At, B0); PG8_MMA(1, 1, At, B1); PG8_BAR; PG8_SCHED;
            PG8_LDB(B0, 1, 0); PG8_LDB(B1, 1, 1); PG8_SCHED; PG8_LDA(At, 1, 0); PG8_STAGE(PG8_SA(0, 1), a2 + hstepA, voffA);
            PG8_WAIT_V(8); PG8_WAIT_L(0); PG8_BAR; PG8_MMA(0, 0, At, B0); PG8_MMA(0, 1, At, B1); PG8_BAR; PG8_SCHED;
            PG8_LDA(At, 1, 1); PG8_STAGE(PG8_SB(1, 0), b3, voffB); PG8_STAGE(PG8_SB(1, 1), b3 + hstepB, voffB); PG8_STAGE(PG8_SA(1, 0), a3, voffA);
            PG8_WAIT_V(8); PG8_WAIT_L(0); PG8_BAR; PG8_MMA(1, 0, At, B0); PG8_MMA(1, 1, At, B1); PG8_BAR; PG8_SCHED;
            } else {
            PG8_LDB(B0, 0, 0); PG8_SCHED; PG8_LDA(At, 0, 0); PG8_STAGE(PG8_SA(1, 1), a1 + hstepA, voffA);
            PG8_WAIT_L(8); PG8_BAR; PG8_WAIT_L(0); PG8_MMA(0, 0, At, B0); PG8_BAR; PG8_SCHED;
            PG8_LDB(B1, 0, 1); PG8_STAGE(PG8_SB(0, 0), b2, voffB);
            PG8_BAR; PG8_WAIT_L(0); PG8_MMA(0, 1, At, B1); PG8_BAR;
            PG8_LDA(At, 0, 1); PG8_STAGE(PG8_SA(0, 0), a2, voffA);
            PG8_BAR; PG8_WAIT_L(0); PG8_MMA(1, 0, At, B0); PG8_BAR; PG8_SCHED;
            PG8_STAGE(PG8_SB(0, 1), b2 + hstepB, voffB);
            PG8_WAIT_V(6); PG8_BAR; PG8_MMA(1, 1, At, B1); PG8_BAR;
            PG8_LDB(B0, 1, 0); PG8_SCHED; PG8_LDA(At, 1, 0); PG8_STAGE(PG8_SA(0, 1), a2 + hstepA, voffA);
            PG8_WAIT_L(8); PG8_BAR; PG8_WAIT_L(0); PG8_MMA(0, 0, At, B0); PG8_BAR; PG8_SCHED;
            PG8_LDB(B1, 1, 1); PG8_STAGE(PG8_SB(1, 0), b3, voffB);
            PG8_BAR; PG8_WAIT_L(0); PG8_MMA(0, 1, At, B1); PG8_BAR;
            PG8_LDA(At, 1, 1); PG8_STAGE(PG8_SA(1, 0), a3, voffA);
            PG8_BAR; PG8_WAIT_L(0); PG8_MMA(1, 0, At, B0); PG8_BAR; PG8_SCHED;
            PG8_STAGE(PG8_SB(1, 1), b3 + hstepB, voffB);
            PG8_WAIT_V(6); PG8_BAR; PG8_MMA(1, 1, At, B1); PG8_BAR;
            }
        }
        if constexpr (ALIGN_EPI) { if (wr == 0) PG8_BAR; }
        if constexpr (!Epi::AFTER_DRAIN) { E(acc, cur, wr, wc, fr, fq); S.done(cur); }
        if (!has_next) break;
#pragma unroll
        for (int a = 0; a < 2; ++a)
#pragma unroll
            for (int b = 0; b < 2; ++b)
#pragma unroll
                for (int m = 0; m < 4; ++m)
#pragma unroll
                    for (int n = 0; n < 2; ++n) acc[a][b][m][n] = (f32x4){0.f, 0.f, 0.f, 0.f};
        cur = nxt; cA = nA; cB = nB; ++ui;
        if constexpr (ALIGN_EPI) { if (wr == 1) PG8_BAR; }
    }
    PG8_WAIT_V(0);
    if constexpr (!ALIGN_EPI) { if (wr == 0) PG8_BAR; }
    PG8_BAR;
    if constexpr (Epi::AFTER_DRAIN) { E.fused(acc, cur, wr, wc, fr, fq, lds, wid, lane); S.done(cur); }
#undef PG8_SA
#undef PG8_SB
#undef PG8_STAGE
#undef PG8_LDA
#undef PG8_LDB
#undef PG8_MMA
#undef PG8_WAIT_V
#undef PG8_WAIT_L
#undef PG8_BAR
#undef PG8_SCHED
}
}
#define DI __device__ __forceinline__
#define LAS __attribute__((address_space(3)))
#define GAS __attribute__((address_space(1)))
using pg8::bf16_t; using pg8::bf16x8; using pg8::f32x4; using pg8::u32x4; using pg8::u32x2; using pg8::pk2; using pg8::f32x2v;
typedef float f32x16 __attribute__((ext_vector_type(16)));
constexpr int TT = pg8::TT, NB = 16, M = NB * TT, DM = 1024, SEQ = 4096;
constexpr int NTILE = M / 256;
constexpr float EPS = 1e-6f;
constexpr size_t MiB = 1u << 20;
constexpr size_t WS_EVIN = 0, WS_EVG = 10 * MiB, WS_EVOUT = 12 * MiB, WS_ODIN = 16 * MiB, WS_UQ = 19 * MiB, WS_UK = 22 * MiB, WS_UV = 23 * MiB, WS_ODOUT = 24 * MiB,
                 WS_UP = 28 * MiB, WS_DOWN = 72 * MiB, WS_COS = 94 * MiB, WS_SIN = 94 * MiB + 512 * 1024, WS_AGG = 95 * MiB, WS_H = 104 * MiB, WS_HB = WS_H + 4096, WS_R = 361 * MiB;
constexpr size_t SZ_EVIN = (size_t)2560 * 1024 * 2, SZ_EVG = (size_t)1024 * 512 * 2, SZ_EVOUT = (size_t)1024 * 1024 * 2, SZ_ODIN = (size_t)768 * 1024 * 2, SZ_UQ = (size_t)1536 * 384 * 2,
                 SZ_UK = (size_t)1024 * 256 * 2, SZ_ODOUT = SZ_EVOUT, SZ_UP = (size_t)5632 * 1024 * 2, SZ_DOWN = (size_t)1024 * 2816 * 2;
constexpr size_t R_U1 = 0, R_GATE = 257 * MiB, R_XC = 322 * MiB, R_Y = 387 * MiB, R_A = 0, R_UU = (size_t)M * 512 * 4;
constexpr size_t R_Q = 0, R_K = 193 * MiB, R_VT = 386 * MiB, R_U2 = R_VT, R_O = 517 * MiB;
constexpr size_t R_G = 0;
constexpr size_t WS_NEED = WS_R + 646 * MiB;
constexpr size_t DO_T = 212 * MiB;
constexpr size_t WS_SS = 97 * MiB;
constexpr size_t DO_HN = 4096, DO_CQN = 129 * MiB, DO_CKVN = 178 * MiB;
constexpr int LDS_BYTES = 131072 + 8192 + 4096;
constexpr int FFN_SPLIT = 129;

struct Params { const float* in[26]; float* out; unsigned char* ws; int ph_lo, ph_hi; };
typedef const __attribute__((address_space(4))) Params* KParams;

DI float bflo(unsigned w) { return __uint_as_float(w << 16); }
DI float bfhi(unsigned w) { return __uint_as_float(w & 0xffff0000u); }
DI void unpack8(const u32x4 w, float* f) { f[0] = bflo(w.x); f[1] = bfhi(w.x); f[2] = bflo(w.y); f[3] = bfhi(w.y); f[4] = bflo(w.z); f[5] = bfhi(w.z); f[6] = bflo(w.w); f[7] = bfhi(w.w); }
DI u32x4 pack8(const float* f) { u32x4 w; w.x = pk2(f[0], f[1]); w.y = pk2(f[2], f[3]); w.z = pk2(f[4], f[5]); w.w = pk2(f[6], f[7]); return w; }
template <int MASK> DI float swz_xor(float v) { return __int_as_float(__builtin_amdgcn_ds_swizzle(__float_as_int(v), (MASK << 10) | 0x1f)); }
DI float half_sum(float v) { auto rr = __builtin_amdgcn_permlane32_swap(__float_as_uint(v), __float_as_uint(v), false, false); return __uint_as_float(rr[0]) + __uint_as_float(rr[1]); }
DI float half_max(float v) { auto rr = __builtin_amdgcn_permlane32_swap(__float_as_uint(v), __float_as_uint(v), false, false); return fmaxf(__uint_as_float(rr[0]), __uint_as_float(rr[1])); }
DI float wave_sum(float v) { v += swz_xor<1>(v); v += swz_xor<2>(v); v += swz_xor<4>(v); v += swz_xor<8>(v); v += swz_xor<16>(v); return half_sum(v); }
DI float bf1(const bf16_t* p) { return __uint_as_float((unsigned)(*(GAS const bf16_t*)p) << 16); }
DI bf16_t tobf(float f) { return (bf16_t)(pk2(f, 0.f) & 0xffffu); }

DI int otid() { int t = threadIdx.x; asm volatile("" : "+v"(t)); return t; }
DI int obid() { int b = blockIdx.x; asm volatile("" : "+s"(b)); return b; }
template <class F> DI void cvt_wT(const float* W, int K, int Ns, bf16_t* Wt, int Nd, F smap, float* sl, const float* gsc = nullptr) {
    const int tid = otid(), tn = Nd / 64, tk = K / 64, total = tn * tk;
    for (int it = obid(); it < total; it += gridDim.x) {
        const int n0 = (it % tn) * 64, k0 = (it / tn) * 64; const int s0 = smap(n0);
        const int j = tid & 63, i = tid >> 6;
        __syncthreads();
#pragma unroll
        for (int r = 0; r < 8; ++r) { const int k = k0 + i * 8 + r; float v = 0.f; if (s0 >= 0 && s0 + j < Ns) v = W[(size_t)k * Ns + s0 + j]; if (gsc) v *= gsc[k]; sl[(i * 8 + r) * 65 + j] = v; }
        __syncthreads();
        const int nl = tid >> 3, kc = tid & 7; float f[8];
#pragma unroll
        for (int e = 0; e < 8; ++e) f[e] = sl[(kc * 8 + e) * 65 + nl];
        *(GAS u32x4*)(Wt + (size_t)(n0 + nl) * K + k0 + kc * 8) = pack8(f);
    }
    __syncthreads();
}
struct MapId { DI int operator()(int n0) const { return n0; } };
struct MapK { DI int operator()(int n0) const { return (n0 >> 6) * 128; } };
struct MapUp { DI int operator()(int n0) const { return ((n0 >> 7) & 1) * 2816 + (n0 >> 8) * 128 + (n0 & 127); } };
struct MapV { DI int operator()(int n0) const { return (n0 >> 6) * 128 + 64; } };

DI void sincos_r(float ang, float& c, float& s) {
    const float n = rintf(ang * 0.15915494309189535f);
    float r = fmaf(-n, 6.28125f, ang); r = fmaf(-n, 1.9353071795864769e-3f, r);
    c = __cosf(r); s = __sinf(r);
}
DI void phase_prologue(KParams P, float* sl) {
    unsigned char* ws = P->ws;
    for (int j = 0; j < 2; ++j) {
        cvt_wT(P->in[3] + (size_t)j * 1024 * 2560, 1024, 2560, (bf16_t*)(ws + WS_EVIN + j * SZ_EVIN), 2560, MapId(), sl, P->in[2] + j * 1024);
        cvt_wT(P->in[12] + (size_t)j * 1024 * 1024, 1024, 1024, (bf16_t*)(ws + WS_EVOUT + j * SZ_EVOUT), 1024, MapId(), sl);
        cvt_wT(P->in[14] + (size_t)j * 1024 * 672, 1024, 672, (bf16_t*)(ws + WS_ODIN + j * SZ_ODIN), 768, MapId(), sl, P->in[13] + j * 1024);
        cvt_wT(P->in[17] + (size_t)j * 384 * 1536, 384, 1536, (bf16_t*)(ws + WS_UQ + j * SZ_UQ), 1536, MapId(), sl);
        cvt_wT(P->in[18] + (size_t)j * 256 * 2048, 256, 2048, (bf16_t*)(ws + WS_UK + j * SZ_UK), 1024, MapK(), sl);
        cvt_wT(P->in[18] + (size_t)j * 256 * 2048, 256, 2048, (bf16_t*)(ws + WS_UV + j * SZ_UK), 1024, MapV(), sl);
        cvt_wT(P->in[19] + (size_t)j * 1024 * 1024, 1024, 1024, (bf16_t*)(ws + WS_ODOUT + j * SZ_ODOUT), 1024, MapId(), sl);
    }
    for (int l = 0; l < 4; ++l) {
        cvt_wT(P->in[21] + (size_t)l * 1024 * 5632, 1024, 5632, (bf16_t*)(ws + WS_UP + l * SZ_UP), 5632, MapUp(), sl, P->in[20] + l * 1024);
        cvt_wT(P->in[24] + (size_t)l * 2816 * 1024, 2816, 1024, (bf16_t*)(ws + WS_DOWN + l * SZ_DOWN), 1024, MapId(), sl);
    }
    const int gtid = obid() * 512 + otid(), nth = gridDim.x * 512;
    for (int idx = gtid; idx < 2 * 1024 * 64; idx += nth) {
        const int j = idx >> 16, rem = idx & 65535, n = rem >> 6, k0 = (rem & 63) * 8;
        const int pn = n >> 8, bj = (n >> 7) & 1, ch = pn * 128 + (n & 127), h = ch >> 6, jj = ch & 63;
        const float* src = (bj ? P->in[9] : P->in[7]) + (size_t)(j * 8 + h) * 4096;
        float f[8];
#pragma unroll
        for (int e = 0; e < 8; ++e) { const int k = k0 + e; f[e] = ((k >> 6) == h) ? src[(k & 63) * 64 + jj] : 0.f; }
        *(GAS u32x4*)((bf16_t*)(ws + WS_EVG + j * SZ_EVG) + (size_t)n * 512 + k0) = pack8(f);
    }
    { bf16_t* HB = (bf16_t*)(ws + WS_HB); float* ss0 = (float*)(ws + WS_SS);
      const int lane = otid() & 63, gw = obid() * 8 + (otid() >> 6), nw = gridDim.x * 8;
      for (int row = gw; row < M; row += nw) {
          const int b = row / TT, t = row % TT;
          GAS const f32x4* src = (GAS const f32x4*)((t < 16) ? P->in[1] + (size_t)t * 1024 : P->in[0] + ((size_t)b * SEQ + (t - 16)) * 1024);
          GAS u32x2* bp = (GAS u32x2*)(HB + (size_t)row * 1024); float sq = 0.f;
#pragma unroll
          for (int i = 0; i < 4; ++i) { const f32x4 v = src[lane + 64 * i]; u32x2 w; w.x = pk2(v[0], v[1]); w.y = pk2(v[2], v[3]); bp[lane + 64 * i] = w;
              sq += (v[0] * v[0] + v[1] * v[1]) + (v[2] * v[2] + v[3] * v[3]); }
          sq = wave_sum(sq); if (lane < 16) ss0[(size_t)row * 16 + lane] = (lane == 0) ? sq : 0.f;
      } }
    float* cs = (float*)(ws + WS_COS); float* sn = (float*)(ws + WS_SIN);
    for (int idx = gtid; idx < TT * 16; idx += nth) {
        const int t = idx >> 4, i = idx & 15;
        const float bb = ((i & 3) == 0) ? 1.0f : ((i & 3) == 1) ? 0.5623413251903491f : ((i & 3) == 2) ? 0.31622776601683794f : 0.1778279410038923f;
        const int e = i >> 2; const float sc = (e == 0) ? 1.0f : (e == 1) ? 0.1f : (e == 2) ? 0.01f : 0.001f;
        const float inv = bb * sc; const float ang = (float)t * inv;
        float c, s; sincos_r(ang, c, s); cs[idx] = c; sn[idx] = s;
    }
}

DI void phase_final(const bf16_t* HB, const float* g, float* out) {
    const int lane = otid() & 63, gw = obid() * 8 + (otid() >> 6), nw = gridDim.x * 8;
    f32x4 g4[4];
#pragma unroll
    for (int i = 0; i < 4; ++i) g4[i] = ((const f32x4*)g)[lane + 64 * i];
    for (int r = gw; r < NB * SEQ; r += nw) {
        const int b = r >> 12, s = r & 4095; const int row = b * TT + 16 + s;
        GAS const u32x2* p = (GAS const u32x2*)(HB + (size_t)row * 1024); f32x4 v[4]; float ss = 0.f;
#pragma unroll
        for (int i = 0; i < 4; ++i) { const u32x2 w = p[lane + 64 * i]; v[i][0] = bflo(w.x); v[i][1] = bfhi(w.x); v[i][2] = bflo(w.y); v[i][3] = bfhi(w.y);
            ss += (v[i][0] * v[i][0] + v[i][1] * v[i][1]) + (v[i][2] * v[i][2] + v[i][3] * v[i][3]); }
        const float rstd = rsqrtf(wave_sum(ss) * (1.f / 1024) + EPS);
        GAS f32x4* o = (GAS f32x4*)(out + (size_t)r * 1024);
#pragma unroll
        for (int i = 0; i < 4; ++i) o[lane + 64 * i] = v[i] * rstd * g4[i];
    }
}

DI void phase_evconv(const bf16_t* U1, const float* ca, const float* cb, const float* cbias, bf16_t* Y, bf16_t* XC) {
    const int lane = otid() & 63, gw = obid() * 8 + (otid() >> 6), nw = gridDim.x * 8; const int c8 = lane * 8;
    float wa[3][8], wb[4][8], bs[8];
#pragma unroll
    for (int k = 0; k < 3; ++k)
#pragma unroll
        for (int e = 0; e < 8; ++e) wa[k][e] = ca[k * 512 + c8 + e];
#pragma unroll
    for (int k = 0; k < 4; ++k)
#pragma unroll
        for (int e = 0; e < 8; ++e) wb[k][e] = cb[k * 512 + c8 + e];
#pragma unroll
    for (int e = 0; e < 8; ++e) bs[e] = cbias[c8 + e];
    for (int ri = gw; ri < M / 16; ri += nw) {
        const int r0 = ri * 16, t0 = r0 % TT;
        float p1[8], p2[8], x1[8], x2[8], x3[8];
#pragma unroll
        for (int e = 0; e < 8; ++e) { p1[e] = p2[e] = x1[e] = x2[e] = x3[e] = 0.f; }
        if (t0 != 0) {
            float a[8], b[8];
            const bf16_t* q1 = U1 + (size_t)(r0 - 1) * 2048 + c8; const bf16_t* q2 = U1 + (size_t)(r0 - 2) * 2048 + c8; const bf16_t* q3 = U1 + (size_t)(r0 - 3) * 2048 + c8;
            unpack8(*(GAS const u32x4*)(q1 + 512), a); unpack8(*(GAS const u32x4*)(q1 + 1024), b);
#pragma unroll
            for (int e = 0; e < 8; ++e) p1[e] = a[e] * b[e];
            unpack8(*(GAS const u32x4*)(q2 + 512), a); unpack8(*(GAS const u32x4*)(q2 + 1024), b);
#pragma unroll
            for (int e = 0; e < 8; ++e) p2[e] = a[e] * b[e];
            unpack8(*(GAS const u32x4*)(q1 + 1536), x1); unpack8(*(GAS const u32x4*)(q2 + 1536), x2); unpack8(*(GAS const u32x4*)(q3 + 1536), x3);
        }
        for (int rr = 0; rr < 16; ++rr) {
            const size_t row = (size_t)(r0 + rr); const bf16_t* q = U1 + row * 2048 + c8;
            float gb[8], gc[8], xa[8], x0[8], p0[8], ya[8], xc[8];
            unpack8(*(GAS const u32x4*)(q), gb); unpack8(*(GAS const u32x4*)(q + 512), gc); unpack8(*(GAS const u32x4*)(q + 1024), xa); unpack8(*(GAS const u32x4*)(q + 1536), x0);
#pragma unroll
            for (int e = 0; e < 8; ++e) {
                p0[e] = gc[e] * xa[e];
                ya[e] = gb[e] * (wa[0][e] * p2[e] + wa[1][e] * p1[e] + wa[2][e] * p0[e]);
                xc[e] = wb[0][e] * x3[e] + wb[1][e] * x2[e] + wb[2][e] * x1[e] + wb[3][e] * x0[e] + bs[e];
                p2[e] = p1[e]; p1[e] = p0[e]; x3[e] = x2[e]; x2[e] = x1[e]; x1[e] = x0[e];
            }
            *(GAS u32x4*)(Y + row * 1024 + c8) = pack8(ya); *(GAS u32x4*)(XC + row * 512 + c8) = pack8(xc);
        }
    }
}

DI void phase_scan1(const bf16_t* A, const bf16_t* U, float* agg) {
    const int ch = otid();
    for (int it = obid(); it < 256; it += gridDim.x) {
        const int b = it >> 4, c = it & 15; const size_t base = ((size_t)b * TT + (size_t)c * 257) * 512 + ch;
        float Pl = 0.f, S = 0.f;
        for (int s0 = 0; s0 < 256; s0 += 8) {
            float a[8], u[8];
#pragma unroll
            for (int e = 0; e < 8; ++e) { a[e] = bf1(A + base + (size_t)(s0 + e) * 512); u[e] = bf1(U + base + (size_t)(s0 + e) * 512); }
#pragma unroll
            for (int e = 0; e < 8; ++e) { S = __expf(a[e]) * S + u[e]; Pl += a[e]; }
        }
        { const float a = bf1(A + base + (size_t)256 * 512), u = bf1(U + base + (size_t)256 * 512); S = __expf(a) * S + u; Pl += a; }
        agg[((size_t)it * 512 + ch) * 2] = __expf(Pl); agg[((size_t)it * 512 + ch) * 2 + 1] = S;
    }
}
DI float gelu_tanh(float x) { const float u = 0.7978845608028654f * (x + 0.044715f * x * x * x); const float e = __expf(2.f * u); const float th = 1.f - 2.f / (e + 1.f); return 0.5f * x * (1.f + th); }
DI void phase_scan2(const bf16_t* A, const bf16_t* U, const float* agg, const bf16_t* GATE, bf16_t* Y) {
    const int ch = otid();
    for (int it = obid(); it < 256; it += gridDim.x) {
        const int b = it >> 4, c = it & 15; const size_t row0 = (size_t)b * TT + (size_t)c * 257; const size_t base = row0 * 512 + ch;
        float h = 0.f;
        for (int cc = 0; cc < c; ++cc) { const float Pp = agg[((size_t)(b * 16 + cc) * 512 + ch) * 2], S = agg[((size_t)(b * 16 + cc) * 512 + ch) * 2 + 1]; h = Pp * h + S; }
        for (int s0 = 0; s0 < 256; s0 += 8) {
            float a[8], u[8], g[8];
#pragma unroll
            for (int e = 0; e < 8; ++e) { a[e] = bf1(A + base + (size_t)(s0 + e) * 512); u[e] = bf1(U + base + (size_t)(s0 + e) * 512); g[e] = bf1(GATE + base + (size_t)(s0 + e) * 512); }
#pragma unroll
            for (int e = 0; e < 8; ++e) { h = __expf(a[e]) * h + u[e]; Y[(row0 + s0 + e) * 1024 + 512 + ch] = tobf(gelu_tanh(g[e]) * h); }
        }
        { const float a = bf1(A + base + (size_t)256 * 512), u = bf1(U + base + (size_t)256 * 512), g = bf1(GATE + base + (size_t)256 * 512); h = __expf(a) * h + u; Y[(row0 + 256) * 1024 + 512 + ch] = tobf(gelu_tanh(g) * h); }
    }
}

DI void phase_oddnorm(const bf16_t* U2, const float* qn, const float* kvn, const float* cs, const float* sn, bf16_t* CQN, bf16_t* CKVN, bf16_t* K) {
    const int lane = otid() & 63, gw = obid() * 8 + (otid() >> 6), nw = gridDim.x * 8;
    float gq[6], gk[4];
#pragma unroll
    for (int e = 0; e < 6; ++e) gq[e] = qn[lane * 6 + e];
#pragma unroll
    for (int e = 0; e < 4; ++e) gk[e] = kvn[lane * 4 + e];
    for (int row = gw; row < M; row += nw) {
        const bf16_t* u = U2 + (size_t)row * 768; const int t = row % TT;
        GAS const unsigned* uq = (GAS const unsigned*)(u + lane * 6); const unsigned w0 = uq[0], w1 = uq[1], w2 = uq[2];
        float q[6] = {bflo(w0), bfhi(w0), bflo(w1), bfhi(w1), bflo(w2), bfhi(w2)};
        float ss = 0.f;
#pragma unroll
        for (int e = 0; e < 6; ++e) ss += q[e] * q[e];
        const float rq = rsqrtf(wave_sum(ss) * (1.f / 384) + EPS);
        GAS unsigned* oq = (GAS unsigned*)(CQN + (size_t)row * 384 + lane * 6);
        oq[0] = pk2(q[0] * rq * gq[0], q[1] * rq * gq[1]); oq[1] = pk2(q[2] * rq * gq[2], q[3] * rq * gq[3]); oq[2] = pk2(q[4] * rq * gq[4], q[5] * rq * gq[5]);
        const u32x2 kw = *(GAS const u32x2*)(u + 384 + lane * 4);
        float kv[4] = {bflo(kw.x), bfhi(kw.x), bflo(kw.y), bfhi(kw.y)};
        float s2 = (kv[0] * kv[0] + kv[1] * kv[1]) + (kv[2] * kv[2] + kv[3] * kv[3]);
        const float rk = rsqrtf(wave_sum(s2) * (1.f / 256) + EPS);
        u32x2 ow; ow.x = pk2(kv[0] * rk * gk[0], kv[1] * rk * gk[1]); ow.y = pk2(kv[2] * rk * gk[2], kv[3] * rk * gk[3]);
        *(GAS u32x2*)(CKVN + (size_t)row * 256 + lane * 4) = ow;
        const float x = bf1(u + 640 + (lane & 31)); const float xp = swz_xor<16>(x);
        const float c = cs[t * 16 + (lane & 15)], s = sn[t * 16 + (lane & 15)];
        const float o = (lane & 16) ? (x * c + xp * s) : (x * c - xp * s);
        const bf16_t ob = tobf(o);
        if (lane < 32) {
            const int b_ = row / TT; bf16_t* kp = K + ((size_t)(b_ * 16) * TT + t) * 96 + 64 + lane;
#pragma unroll
            for (int h = 0; h < 16; ++h) kp[(size_t)h * TT * 96] = ob;
        }
    }
}

constexpr int KPITCH = 208, VPITCH = 144, KBUF = 64 * KPITCH, VBUF = 64 * VPITCH;
DI f32x16 mfma32(bf16x8 a, bf16x8 b, f32x16 c) { return __builtin_amdgcn_mfma_f32_32x32x16_bf16(a, b, c, 0, 0, 0); }
template <int VAR> DI void phase_attn(LAS unsigned char* lds, const bf16_t* Q, const bf16_t* K, const bf16_t* VT, bf16_t* O) {
    const int tid = otid(), lane = tid & 63, r32 = lane & 31, hi = lane >> 5; const int wid = __builtin_amdgcn_readfirstlane(tid >> 6);
    LAS unsigned char* kbuf = lds; LAS unsigned char* vbuf = lds + 2 * KBUF;
    const int krow0 = tid / 12, kch0 = tid % 12; const int id1 = tid + 512; const int krow1 = id1 / 12, kch1 = id1 % 12; const bool k2 = id1 < 768;
    const int vd = tid >> 3, vch = tid & 7;
    const int bid_ = obid(); const bool latin = (gridDim.x == 256);
    const int nsteps = latin ? 17 : (17 * 256 - bid_ + (int)gridDim.x - 1) / (int)gridDim.x;
    for (int st = 0; st < nsteps; ++st) {
        int qb, bh;
        if (latin) { const int x = bid_ & 7, li = bid_ >> 3, g = li >> 4, i = li & 15; const int base = x * 32 + g * 16;
            if (st < 16) { bh = base + st; qb = (i + st) % 17; } else { bh = base + i; qb = (i + 16) % 17; } }
        else { const int u = bid_ + st * (int)gridDim.x; qb = 16 - (u >> 8); bh = u & 255; }
        const int b = bh >> 4, h = bh & 15; const int q0 = qb * 256;
        const size_t rowb = (size_t)b * TT;
        const int qlast = (q0 + 255 < TT - 1) ? q0 + 255 : TT - 1; const int ntiles = (qlast >> 6) + 1;
        const int qw0 = q0 + 32 * wid; const bool wvalid = qw0 < TT;
        int my_last = (qw0 + 31) >> 6; if (my_last > ntiles - 1) my_last = ntiles - 1; if (!wvalid) my_last = -1;
        int tq = qw0 + r32; if (tq > TT - 1) tq = TT - 1;
        bf16x8 qr[6];
        { const bf16_t* qp = Q + (rowb + tq) * 1536 + h * 96 + 8 * hi;
#pragma unroll
          for (int s = 0; s < 6; ++s) qr[s] = *(GAS const bf16x8*)(qp + 16 * s); }
        const bf16_t* Kh = K + (size_t)bh * TT * 96; const bf16_t* Vh = VT + (size_t)(bh * 64 + vd) * 4160;
        u32x4 kr0, kr1 = {0u, 0u, 0u, 0u}, vr;
#define ATT_LOAD(j) do { int ra = 64 * (j) + krow0; if (ra > TT - 1) ra = TT - 1; kr0 = *(GAS const u32x4*)(Kh + (size_t)ra * 96 + kch0 * 8); \
            if (k2) { int rb = 64 * (j) + krow1; if (rb > TT - 1) rb = TT - 1; kr1 = *(GAS const u32x4*)(Kh + (size_t)rb * 96 + kch1 * 8); } \
            vr = *(GAS const u32x4*)(Vh + 64 * (j) + vch * 8); } while (0)
#define ATT_STORE(bufi) do { *(LAS u32x4*)(kbuf + (bufi) * KBUF + krow0 * KPITCH + kch0 * 16) = kr0; if (k2) *(LAS u32x4*)(kbuf + (bufi) * KBUF + krow1 * KPITCH + kch1 * 16) = kr1; \
            { LAS unsigned char* vp_ = vbuf + (bufi) * VBUF + vd * VPITCH + (vch >> 1) * 32 + (vch & 1) * 8; u32x2 lo_ = {vr.x, vr.y}, hi_ = {vr.z, vr.w}; *(LAS u32x2*)vp_ = lo_; *(LAS u32x2*)(vp_ + 16) = hi_; } } while (0)
        ATT_LOAD(0); ATT_STORE(0);
        __syncthreads();
        float mrun = 0.f, lrun = 0.f; f32x16 o0, o1;
#pragma unroll
        for (int r = 0; r < 16; ++r) { o0[r] = 0.f; o1[r] = 0.f; }
        for (int j = 0; j < ntiles; ++j) {
            const int buf = j & 1;
            if (VAR != 3 && j + 1 < ntiles) ATT_LOAD(j + 1);
            if (VAR != 4 && j <= my_last) {
                LAS const unsigned char* kb = kbuf + buf * KBUF + r32 * KPITCH + 16 * hi; LAS const unsigned char* vb = vbuf + buf * VBUF + r32 * VPITCH + 16 * hi;
                f32x16 p0, p1;
#pragma unroll
                for (int r = 0; r < 16; ++r) { p0[r] = -mrun; p1[r] = -mrun; }
                bf16x8 ka[12], va[8];
#pragma unroll
                for (int s = 0; s < 6; ++s) { ka[2 * s] = *(LAS const bf16x8*)(kb + 32 * s); ka[2 * s + 1] = *(LAS const bf16x8*)(kb + 32 * KPITCH + 32 * s); }
#pragma unroll
                for (int f = 0; f < 4; ++f) { va[2 * f] = *(LAS const bf16x8*)(vb + 32 * f); va[2 * f + 1] = *(LAS const bf16x8*)(vb + 32 * VPITCH + 32 * f); }
                __builtin_amdgcn_sched_barrier(0);
#pragma unroll
                for (int s = 0; s < 6; ++s) { if (VAR == 2) { p0[s] += __builtin_bit_cast(f32x4, ka[2 * s])[0]; p1[s] += __builtin_bit_cast(f32x4, ka[2 * s + 1])[1]; } else { p0 = mfma32(ka[2 * s], qr[s], p0); p1 = mfma32(ka[2 * s + 1], qr[s], p1); } }
                if (64 * j + 63 > qw0) {
                    const int qa = qw0 + r32, kb0 = 64 * j + 4 * hi;
#pragma unroll
                    for (int r = 0; r < 16; ++r) { const int kv = kb0 + (r & 3) + 8 * (r >> 2); if (kv > qa) p0[r] = -INFINITY; if (kv + 32 > qa) p1[r] = -INFINITY; }
                }
                float mx;
                { float a_ = __builtin_fmaxf(__builtin_fmaxf(p0[0], p0[1]), p1[0]), b_ = __builtin_fmaxf(__builtin_fmaxf(p0[2], p0[3]), p1[1]); a_ = __builtin_fmaxf(__builtin_fmaxf(a_, p1[2]), p1[3]);
#pragma unroll
                  for (int r = 4; r < 16; r += 4) { a_ = __builtin_fmaxf(__builtin_fmaxf(a_, p0[r]), p0[r + 1]); b_ = __builtin_fmaxf(__builtin_fmaxf(b_, p0[r + 2]), p0[r + 3]);
                      a_ = __builtin_fmaxf(__builtin_fmaxf(a_, p1[r]), p1[r + 1]); b_ = __builtin_fmaxf(__builtin_fmaxf(b_, p1[r + 2]), p1[r + 3]); }
                  mx = half_max(__builtin_fmaxf(a_, b_)); }
                if (j == 0) {
                    mrun = mx;
#pragma unroll
                    for (int r = 0; r < 16; ++r) { p0[r] -= mx; p1[r] -= mx; }
                } else if (__any(mx > 0.f)) {
                    const float dl = __builtin_fmaxf(mx, 0.f); mrun += dl; const float fsc = __builtin_amdgcn_exp2f(-dl); lrun *= fsc;
#pragma unroll
                    for (int r = 0; r < 16; ++r) { p0[r] -= dl; p1[r] -= dl; o0[r] *= fsc; o1[r] *= fsc; }
                }
                float ls = 0.f;
#pragma unroll
                for (int r = 0; r < 16; ++r) { if (VAR != 1) { p0[r] = __builtin_amdgcn_exp2f(p0[r]); p1[r] = __builtin_amdgcn_exp2f(p1[r]); } }
#pragma unroll
                for (int r = 0; r < 16; r += 2) ls += (p0[r] + p0[r + 1]) + (p1[r] + p1[r + 1]);
                lrun += ls;
                bf16x8 pf[4];
                { u32x4 w;
                  w.x = pk2(p0[0], p0[1]); w.y = pk2(p0[2], p0[3]); w.z = pk2(p0[4], p0[5]); w.w = pk2(p0[6], p0[7]); pf[0] = __builtin_bit_cast(bf16x8, w);
                  w.x = pk2(p0[8], p0[9]); w.y = pk2(p0[10], p0[11]); w.z = pk2(p0[12], p0[13]); w.w = pk2(p0[14], p0[15]); pf[1] = __builtin_bit_cast(bf16x8, w);
                  w.x = pk2(p1[0], p1[1]); w.y = pk2(p1[2], p1[3]); w.z = pk2(p1[4], p1[5]); w.w = pk2(p1[6], p1[7]); pf[2] = __builtin_bit_cast(bf16x8, w);
                  w.x = pk2(p1[8], p1[9]); w.y = pk2(p1[10], p1[11]); w.z = pk2(p1[12], p1[13]); w.w = pk2(p1[14], p1[15]); pf[3] = __builtin_bit_cast(bf16x8, w); }
#pragma unroll
                for (int f = 0; f < 4; ++f) { if (VAR == 2) { o0[f] += __builtin_bit_cast(f32x4, va[2 * f])[0] * __builtin_bit_cast(f32x4, pf[f])[1]; o1[f] += __builtin_bit_cast(f32x4, va[2 * f + 1])[2]; } else { o0 = mfma32(va[2 * f], pf[f], o0); o1 = mfma32(va[2 * f + 1], pf[f], o1); } }
            }
            if (VAR != 3 && j + 1 < ntiles) ATT_STORE(buf ^ 1);
            __syncthreads();
        }
        const float lt = half_sum(lrun);
        if (qw0 + r32 < TT) {
            const float inv = 1.f / lt; bf16_t* op = O + (rowb + qw0 + r32) * 1024 + h * 64 + 4 * hi;
#pragma unroll
            for (int g = 0; g < 4; ++g) {
                u32x2 w; w.x = pk2(o0[4 * g] * inv, o0[4 * g + 1] * inv); w.y = pk2(o0[4 * g + 2] * inv, o0[4 * g + 3] * inv); *(GAS u32x2*)(op + 8 * g) = w;
                w.x = pk2(o1[4 * g] * inv, o1[4 * g + 1] * inv); w.y = pk2(o1[4 * g + 2] * inv, o1[4 * g + 3] * inv); *(GAS u32x2*)(op + 32 + 8 * g) = w;
            }
        }
    }
#undef ATT_LOAD
#undef ATT_STORE
}

DI void phase_tailfin(bf16_t* HB, const float* T, int nsl, float* ss, LAS float* sl) {
    const int tid = otid(), lane = tid & 63, wid = tid >> 6;
    for (int r = obid(); r < 256; r += gridDim.x) {
        const size_t row = 65536 + r; GAS unsigned* hp = (GAS unsigned*)(HB + row * 1024) + tid; GAS const f32x2v* tp = (GAS const f32x2v*)(T + (size_t)r * 1024) + tid;
        const unsigned h = *hp; float v0 = bflo(h), v1 = bfhi(h);
        float t0 = 0.f, t1 = 0.f;
        for (int s = 0; s < nsl; ++s) { const f32x2v t = tp[(size_t)s * (256 * 512)]; t0 += t[0]; t1 += t[1]; }
        v0 += t0; v1 += t1;
        *hp = pk2(v0, v1);
        const float sq = wave_sum(v0 * v0 + v1 * v1);
        __syncthreads();
        if (lane == 0) sl[wid] = sq;
        __syncthreads();
        if (tid < 16) { float tot = 0.f; if (tid == 0) { for (int w = 0; w < 8; ++w) tot += sl[w]; } *(GAS float*)(ss + row * 16 + tid) = tot; }
    }
    __syncthreads();
}

constexpr int N_PHASES = 1 + 2 * 10 + 2 * 11 + 1;
#ifndef PG8_SP2_FLAG
#define PG8_SP2_FLAG true
#endif
#ifndef PROBE_MASK
#define PROBE_MASK 0
#endif
constexpr size_t WS_BAR = 96 * MiB;
DI void grid_bar(unsigned* w) {
    asm volatile("s_waitcnt vmcnt(0)" ::: "memory");
    __syncthreads();
    if (threadIdx.x == 0) {
        __builtin_amdgcn_fence(__ATOMIC_RELEASE, "agent");
        asm volatile("s_waitcnt vmcnt(0)" ::: "memory");
        const unsigned g = blockIdx.x & 7u, ng = gridDim.x >> 3, lg = 31u - (unsigned)__builtin_clz(ng);
        const unsigned old = __hip_atomic_fetch_add(w + 64 * g, 1u, __ATOMIC_RELAXED, __HIP_MEMORY_SCOPE_AGENT);
        const unsigned gen = old >> lg;
        if ((old & (ng - 1u)) == ng - 1u) {
            const unsigned o2 = __hip_atomic_fetch_add(w + 64 * 16, 1u, __ATOMIC_RELAXED, __HIP_MEMORY_SCOPE_AGENT);
            if ((o2 & 7u) == 7u) {
#pragma unroll
                for (int j = 0; j < 8; ++j) (void)__hip_atomic_fetch_add(w + 64 * (8 + j), 1u, __ATOMIC_RELAXED, __HIP_MEMORY_SCOPE_AGENT);
            }
        }
        while (__hip_atomic_load(w + 64 * (8 + g), __ATOMIC_RELAXED, __HIP_MEMORY_SCOPE_AGENT) <= gen) __builtin_amdgcn_s_sleep(1);
        __builtin_amdgcn_fence(__ATOMIC_ACQUIRE, "agent");
        asm volatile("s_waitcnt vmcnt(0)" ::: "memory");
    }
    __syncthreads();
}
DI int probe_reps(int ph) {
    if (PROBE_MASK == 0) return 1;
    if (ph == 0 || ph == N_PHASES - 1) return ((PROBE_MASK >> 12) & 1) ? 2 : 1;
    int layer = 0, r = ph - 1;
    if (r >= 31) { layer = 3; r -= 31; } else if (r >= 21) { layer = 2; r -= 21; } else if (r >= 10) { layer = 1; r -= 10; }
    const int nmix = (layer & 1) ? 8 : 7; int kind = 0;
    if (r < nmix) { if ((layer & 1) == 0) { const int k[7] = {9, 2, 10, 3, 4, 0, 14}; kind = k[r]; } else { const int k[8] = {9, 5, 11, 11, 11, 6, 0, 14}; kind = k[r]; } }
    else { r -= nmix; kind = (r == 0) ? 8 : (r == 1) ? 0 : 14; }
#ifdef PROBE_RESID
    if (kind == 0 && ph != 0 && ph != N_PHASES - 1) { int l2 = 0, r2 = ph - 1; if (r2 >= 25) { l2 = 3; r2 -= 25; } else if (r2 >= 17) { l2 = 2; r2 -= 17; } else if (r2 >= 8) { l2 = 1; r2 -= 8; } const int nm2 = (l2 & 1) ? 7 : 6; if (r2 == nm2 - 1 || r2 == nm2 + 1) return 2; }
#endif
    if (((PROBE_MASK >> 13) & 1) && (kind == 8 || kind == 9 || kind == 10 || kind == 11 || kind == 0)) return 2;
    return ((PROBE_MASK >> kind) & 1) ? 2 : 1;
}
__global__ void __launch_bounds__(512, 2) mega(Params Pkarg) {
    extern __shared__ __attribute__((aligned(16))) unsigned char smem[];
    cg::grid_group grid = cg::this_grid();
    LAS unsigned char* lds = (LAS unsigned char*)smem;
    const int lo = Pkarg.ph_lo, hi = Pkarg.ph_hi;
    unsigned* barw = (unsigned*)(Pkarg.ws + WS_BAR);
    if (blockIdx.x == 0 && threadIdx.x < 17) __hip_atomic_store(barw + 64 * threadIdx.x, 0u, __ATOMIC_RELAXED, __HIP_MEMORY_SCOPE_AGENT);
    for (int ph = lo; ph < hi; ++ph) {
        int kz = 0; asm volatile("" : "+s"(kz));
        KParams P = (KParams)((const __attribute__((address_space(4))) char*)__builtin_amdgcn_kernarg_segment_ptr() + kz);
        unsigned char* ws = P->ws; unsigned char* dob = (unsigned char*)P->out;
        asm volatile("" : "+s"(ws), "+s"(dob));
        const float* cs = (const float*)(ws + WS_COS); const float* sn = (const float*)(ws + WS_SIN);
        unsigned char* R = ws + WS_R;
        bool do_sync = true;
        for (int rep = probe_reps(ph); rep > 0; --rep) {
        int layer = 0, r = ph - 1;
        if (ph == 0) { phase_prologue(P, (float*)smem); }
        else if (ph == N_PHASES - 1) { phase_final((const bf16_t*)(ws + WS_HB), P->in[25], P->out); }
        else {
            if (r >= 31) { layer = 3; r -= 31; } else if (r >= 21) { layer = 2; r -= 21; } else if (r >= 10) { layer = 1; r -= 10; }
            const int j = layer >> 1; const int nmix = (layer & 1) ? 8 : 7;
            int gk = -1; const bf16_t* gA = nullptr; const void* gB = nullptr; int gM = 0, gN = 0, gK = 0, gld = 0; size_t gAt = 0, gBt = 0, gApn = 0;
            pg8::EpiAny E{}; E.i2 = 1 << 30;
            bf16_t* HB = (bf16_t*)(ws + WS_HB); float* SS0 = (float*)(ws + WS_SS); float* SS1 = SS0; float* tf_ss = nullptr; int tf_n = 0;
            bf16_t* U1 = (bf16_t*)(R + R_U1); bf16_t* GATE = (bf16_t*)(R + R_GATE); bf16_t* XC = (bf16_t*)(R + R_XC); bf16_t* Y = (bf16_t*)(R + R_Y);
            bf16_t* A = (bf16_t*)(R + R_A); bf16_t* UU = (bf16_t*)(R + R_UU); float* agg = (float*)(ws + WS_AGG);
            bf16_t* U2 = (bf16_t*)(R + R_U2); bf16_t* CQN = (bf16_t*)(dob + DO_CQN); bf16_t* CKVN = (bf16_t*)(dob + DO_CKVN);
            bf16_t* Qb = (bf16_t*)(R + R_Q); bf16_t* Kb = (bf16_t*)(R + R_K); bf16_t* VT = (bf16_t*)(R + R_VT); bf16_t* Ob = (bf16_t*)(R + R_O);
            bf16_t* Gb = (bf16_t*)(R + R_G);
            if (r < nmix) {
                if ((layer & 1) == 0) {
                    if (r == 0) { gk = 0; gA = HB; gB = ws + WS_EVIN + j * SZ_EVIN; gM = M; gN = 2560; gK = 1024; E.p0 = U1; E.i0 = 2048; E.p1 = GATE; E.i1 = 512; E.i2 = 2048; E.f2 = SS0; }
                    else if (r == 1) phase_evconv(U1, P->in[4] + j * 3 * 512, P->in[5] + j * 4 * 512, P->in[6] + j * 512, Y, XC);
                    else if (r == 2) { gk = 3; gA = XC; gB = ws + WS_EVG + j * SZ_EVG; gM = M; gN = 1024; gK = 128; gld = 512; gApn = 256; gBt = (size_t)512 * 512 + 256;
                                       E.p0 = A; E.p1 = XC; E.p2 = UU; E.f0 = P->in[8] + j * 512; E.f1 = P->in[10] + j * 512; E.f2 = P->in[11] + j * 512; }
                    else if (r == 3) phase_scan1(A, UU, agg);
                    else if (r == 4) phase_scan2(A, UU, agg, GATE, Y);
                    else if (r == 5) { gk = 2; gA = Y; gB = ws + WS_EVOUT + j * SZ_EVOUT; gM = M; gN = 1024; gK = 1024; E.i0 = 1024; E.p1 = HB; E.p2 = SS1; }
                    else { tf_ss = SS1; tf_n = 8; }
                } else {
                    if (r == 0) { gk = 0; gA = HB; gB = ws + WS_ODIN + j * SZ_ODIN; gM = M; gN = 768; gK = 1024; E.p0 = U2; E.i0 = 768; E.p1 = U2; E.i1 = 768; E.f2 = SS0; }
                    else if (r == 1) phase_oddnorm(U2, P->in[15] + j * 384, P->in[16] + j * 256, cs, sn, CQN, CKVN, Kb);
                    else if (r == 2) { gk = 4; gA = CQN; gB = ws + WS_UQ + j * SZ_UQ; gM = M; gN = 1536; gK = 384; E.p0 = Qb; E.f0 = cs; E.f1 = sn; E.scale = 0.14724444f; do_sync = false; }
                    else if (r == 3) { gk = 1; gA = CKVN; gB = ws + WS_UK + j * SZ_UK; gM = M; gN = 1024; gK = 256; E.p0 = Kb; E.i0 = 1536; do_sync = false; }
                    else if (r == 4) { gk = 6; gA = (const bf16_t*)(ws + WS_UV + j * SZ_UK); gB = CKVN; gM = 1024; gN = M; gK = 256; E.p0 = VT; E.i0 = 4160; }
                    else if (r == 5) {
#ifdef ATT_VAR
                        if (rep == 1) phase_attn<ATT_VAR>(lds, Qb, Kb, VT, (bf16_t*)dob); else
#endif
                        phase_attn<0>(lds, Qb, Kb, VT, Ob); }
                    else if (r == 6) { gk = 2; gA = Ob; gB = ws + WS_ODOUT + j * SZ_ODOUT; gM = M; gN = 1024; gK = 1024; E.i0 = 1024; E.p1 = HB; E.p2 = SS1; }
                    else { tf_ss = SS1; tf_n = 8; }
                }
            } else {
                r -= nmix;
                if (r == 0) { gk = 5; gA = HB - 2 * 1024; gB = ws + WS_UP + layer * SZ_UP; gM = 260 * 256; gN = 5632; gK = 1024; gAt = (size_t)254 * 1024 * 2;
                              E.p0 = Gb; E.f0 = P->in[22] + (size_t)layer * 3 * 5632; E.f1 = P->in[23] + (size_t)layer * 5632; E.i0 = M; E.halo = (LAS float*)(lds + 131072); E.f2 = SS1; }
                else if (r == 1) { gk = 2; gA = Gb; gB = ws + WS_DOWN + layer * SZ_DOWN; gM = M; gN = 1024; gK = 2816; E.i0 = 1024; E.p1 = HB; E.p2 = SS0; }
                else { tf_ss = SS0; tf_n = 22; }
            }
            if (tf_ss) phase_tailfin(HB, (const float*)(dob + DO_T), tf_n, tf_ss, (LAS float*)lds);
            if (gk >= 0) {
                E.kind = gk;
#ifdef PROBE_RESID
                if (gk == 2 && rep == 1 && probe_reps(ph) == 2) { E.p1 = dob; E.p2 = dob + 160 * MiB; }
#endif
#if ((PROBE_MASK >> 13) & 1) || defined(PROBE_NOEPI)
                if (rep == 1 && probe_reps(ph) == 2) { E.kind = 7; E.p0 = dob; }
#endif
                const int ld = gld ? gld : gK;
                const int npass = (gk == 2) ? 2 : 1;
                for (int pass = 0; pass < npass; ++pass) {
                    pg8::Gemm g{gA, (const bf16_t*)gB, gM, gN, gK, ld, ld, gAt ? gAt : (size_t)512 * ld, gBt ? gBt : (size_t)512 * ld, gApn, 0};
                    if (gk == 2) {
                        if (pass == 0) g.M = 65536;
                        else { g.A = gA + (size_t)65536 * ld; g.M = (gK / 128) * 256; g.K = 128; g.atstep = 256; g.b_pm = 256; E.kind = 8; E.p0 = dob + DO_T; }
                    }
                    pg8::StaticOrder S; S.init(g.M, g.N, (int)gridDim.x, (int)blockIdx.x);
                    pg8::gemm_phase<pg8::EpiAny, pg8::StaticOrder, true, PG8_SP2_FLAG>(lds, g, S, E);
                }
            }
        }
        }
#ifdef IDLE_PROBE
        if (ph == 5 || ph == 20) for (int i = 0; i < 128; ++i) __builtin_amdgcn_s_sleep(127);
#endif
        if (do_sync && ph + 1 < hi) { if (ph == lo) grid.sync(); else grid_bar(barw); }
    }
}

#ifndef MULTI_LAUNCH
#define MULTI_LAUNCH 0
#endif
extern "C" void kernel_launch(void* const* d_in, const int* in_sizes, int n_in, void* d_out, int out_size, void* d_ws, size_t ws_size, hipStream_t stream) {
    static int grid = 0;
    if (grid == 0) {
        if (n_in != 26 || ws_size < WS_NEED || out_size != NB * SEQ * DM) { fprintf(stderr, "kernel_launch: unexpected problem (n_in %d, ws %zu, out %d)\n", n_in, ws_size, out_size); grid = -1; return; }
        int dev = 0, cus = 0, per_cu = 0;
        hipGetDevice(&dev); hipDeviceGetAttribute(&cus, hipDeviceAttributeMultiprocessorCount, dev);
        if (hipFuncSetAttribute((const void*)mega, hipFuncAttributeMaxDynamicSharedMemorySize, LDS_BYTES) != hipSuccess) { fprintf(stderr, "kernel_launch: hipFuncSetAttribute failed\n"); grid = -1; return; }
        if (hipOccupancyMaxActiveBlocksPerMultiprocessor(&per_cu, (const void*)mega, 512, LDS_BYTES) != hipSuccess || per_cu < 1) { fprintf(stderr, "kernel_launch: occupancy query failed (%d)\n", per_cu); per_cu = 1; }
        (void)hipGetLastError();
        grid = 1; while (grid * 2 <= cus * per_cu) grid *= 2;
        fprintf(stderr, "kernel_launch: grid %d (cus %d x %d)\n", grid, cus, per_cu);
    }
    if (grid < 0) return;
    Params p{};
    for (int i = 0; i < 26; ++i) p.in[i] = (const float*)d_in[i];
    p.out = (float*)d_out; p.ws = (unsigned char*)d_ws;
#if MULTI_LAUNCH
    for (int i = 0; i < N_PHASES; ++i) { p.ph_lo = i; p.ph_hi = i + 1; hipLaunchKernelGGL(mega, dim3(grid), dim3(512), LDS_BYTES, stream, p); }
#else
    p.ph_lo = 0; p.ph_hi = N_PHASES;
    void* args[] = {&p};
    hipError_t e = hipLaunchCooperativeKernel((const void*)mega, dim3(grid), dim3(512), args, LDS_BYTES, stream);
    if (e != hipSuccess) fprintf(stderr, "cooperative launch failed: %s (grid %d)\n", hipGetErrorString(e), grid);
#endif
}
```

```cpp
#include <hip/hip_runtime.h>
#include <hip/hip_cooperative_groups.h>
#include <cstdio>
#include <cstdint>
namespace cg = cooperative_groups;
namespace pg8 {
#define PG8_LAS __attribute__((address_space(3)))
typedef unsigned short bf16_t;
typedef short bf16x8 __attribute__((ext_vector_type(8)));
typedef float f32x4 __attribute__((ext_vector_type(4)));
typedef unsigned u32x4 __attribute__((ext_vector_type(4)));
constexpr int BM = 256, BK = 64, HALF = 128, HTB = HALF * BK * 2  , STAGE_BYTES = 8 * HTB, NXCD = 8, WGM = 8;

__host__ __device__ __forceinline__ int lds_byte(int r, int c) { const int st = (r >> 4) * 2 + (c >> 5), rr = r & 15, cc = c & 31, ob = rr * 64 + cc * 2; return st * 1024 + (ob ^ (((ob >> 9) & 1) << 5)); }
__host__ __device__ __forceinline__ void stage_rc(int b, int& R, int& C) { const int st = b / 1024, sb = b % 1024, swz = sb ^ (((sb >> 9) & 1) << 5); R = (st >> 1) * 16 + swz / 64; C = (st & 1) * 32 + (swz % 64) / 2; }
__host__ __device__ __forceinline__ int perm32(int rho) { const int n = rho >> 4, i = rho & 15; return 8 * (i >> 2) + 4 * n + (i & 3); }

struct Unit { int pm, pn; };
struct Gemm { const bf16_t* A; const bf16_t* Bt; int M, N, K; int lda, ldb; size_t atstep, btstep, a_pn, b_pm; };

struct StaticOrder {
    int nM, nN, nwg, G, c, rev = 0;
    __host__ __device__ void init(int M, int N, int G_, int c_) { nM = M / BM; nN = N / BM; nwg = nM * nN; G = G_; c = c_; }
    __host__ __device__ bool next(int i, Unit& u) const {
        const long L = (long)i * G + c; if (L >= nwg) return false;
        int wgid = (int)L; { const int q = nwg / NXCD, r = nwg % NXCD, xcd = wgid % NXCD, off = wgid / NXCD; wgid = (xcd < r ? xcd * (q + 1) : r * (q + 1) + (xcd - r) * q) + off; }
        const int nig = WGM * nN, gid = wgid / nig, fm = gid * WGM, gsz = (nM - fm) < WGM ? (nM - fm) : WGM;
        u.pm = fm + ((wgid % nig) % gsz); u.pn = (wgid % nig) / gsz; if (rev) u.pm = nM - 1 - u.pm; return true;
    }
    __device__ __forceinline__ void a_ready(const Unit&) const {}
    __device__ __forceinline__ void done(const Unit&) const {}
};

__device__ __forceinline__ unsigned cvt_pk_bf16(float lo, float hi) { unsigned r; asm volatile("v_cvt_pk_bf16_f32 %0, %1, %2" : "=v"(r) : "v"(lo), "v"(hi)); return r; }
#define GAS __attribute__((address_space(1)))
typedef unsigned u32x2 __attribute__((ext_vector_type(2)));
typedef float f32x2v __attribute__((ext_vector_type(2)));
typedef __bf16 bf16x2v __attribute__((ext_vector_type(2)));
__device__ __forceinline__ unsigned pk2(float lo, float hi) { f32x2v v = {lo, hi}; bf16x2v b = __builtin_convertvector(v, bf16x2v); return __builtin_bit_cast(unsigned, b); }
constexpr int TT = 4112;

__device__ __forceinline__ float row_rstd(const float* ss, int row, int fq) {
    const f32x4 a = *(GAS const f32x4*)(ss + (size_t)row * 16 + 4 * fq);
    float s = (a[0] + a[1]) + (a[2] + a[3]);
    s += __int_as_float(__builtin_amdgcn_ds_swizzle(__float_as_int(s), (16 << 10) | 0x1f));
    { auto rr = __builtin_amdgcn_permlane32_swap(__float_as_uint(s), __float_as_uint(s), false, false); s = __uint_as_float(rr[0]) + __uint_as_float(rr[1]); }
    return rsqrtf(s * (1.f / 1024) + 1e-6f);
}
template <int MODE> struct EpiStore {
    static constexpr bool PERM = true, AFTER_DRAIN = false;
    bf16_t* O; int ldc; bf16_t* O2; int ld2; int split; const float* ss;
    __device__ __forceinline__ void operator()(const f32x4 (&acc)[2][2][4][2], const Unit& u, int wr, int wc, int fr, int fq) const {
        const int row0 = u.pm * BM + wr * 64 + fr; const int ct = u.pn * BM;
        bf16_t* base = O; int ld = ldc; int c0 = ct + wc * 32 + 8 * fq;
        if (ct >= split) { base = O2; ld = ld2; c0 -= split; }
#pragma unroll
        for (int ai = 0; ai < 2; ++ai)
#pragma unroll
            for (int m = 0; m < 4; ++m) { const int row = row0 + ai * HALF + m * 16; bf16_t* rp = base + (size_t)row * ld;
                float rs = 1.f; if (MODE == 0 && ss) rs = row_rstd(ss, row, fq);
#pragma unroll
                for (int bj = 0; bj < 2; ++bj) { int c = c0 + bj * HALF;
                    if (MODE == 1) { const int b_ = row / TT, t_ = row - b_ * TT; rp = base; c = (((b_ * 16 + (c >> 6)) * TT + t_) * 96) + (c & 63); }
                    if (MODE == 2) { const int b_ = c / TT, t_ = c - b_ * TT; rp = base + ((size_t)((b_ * 16 + (row >> 6)) * 64 + (row & 63))) * 4160; c = t_; }
                    const f32x4 v0 = acc[ai][bj][m][0] * rs, v1 = acc[ai][bj][m][1] * rs; u32x4 w; w.x = pk2(v0[0], v0[1]); w.y = pk2(v0[2], v0[3]); w.z = pk2(v1[0], v1[1]); w.w = pk2(v1[2], v1[3]);
                    *(GAS u32x4*)(rp + c) = w; } }
    }
};
struct EpiResid {
    static constexpr bool PERM = true, AFTER_DRAIN = false;
    bf16_t* HB; int ld; float* ss;
    __device__ __forceinline__ void operator()(const f32x4 (&acc)[2][2][4][2], const Unit& u, int wr, int wc, int fr, int fq) const {
        const int row0 = u.pm * BM + wr * 64 + fr; const int c0 = u.pn * BM + wc * 32 + 8 * fq;
#pragma unroll
        for (int ai = 0; ai < 2; ++ai)
#pragma unroll
            for (int m = 0; m < 4; ++m) { const int row = row0 + ai * HALF + m * 16; bf16_t* bp = HB + (size_t)row * ld + c0; float sq = 0.f;
#pragma unroll
                for (int bj = 0; bj < 2; ++bj) { GAS u32x4* p = (GAS u32x4*)(bp + bj * HALF); const u32x4 h = *p; const f32x4 a0 = acc[ai][bj][m][0], a1 = acc[ai][bj][m][1];
                    const float v0 = __uint_as_float(h.x << 16) + a0[0], v1 = __uint_as_float(h.x & 0xffff0000u) + a0[1], v2 = __uint_as_float(h.y << 16) + a0[2], v3 = __uint_as_float(h.y & 0xffff0000u) + a0[3];
                    const float v4 = __uint_as_float(h.z << 16) + a1[0], v5 = __uint_as_float(h.z & 0xffff0000u) + a1[1], v6 = __uint_as_float(h.w << 16) + a1[2], v7 = __uint_as_float(h.w & 0xffff0000u) + a1[3];
                    u32x4 w; w.x = pk2(v0, v1); w.y = pk2(v2, v3); w.z = pk2(v4, v5); w.w = pk2(v6, v7); *p = w;
                    sq += ((v0 * v0 + v1 * v1) + (v2 * v2 + v3 * v3)) + ((v4 * v4 + v5 * v5) + (v6 * v6 + v7 * v7)); }
                sq += __int_as_float(__builtin_amdgcn_ds_swizzle(__float_as_int(sq), (16 << 10) | 0x1f));
                { auto rr = __builtin_amdgcn_permlane32_swap(__float_as_uint(sq), __float_as_uint(sq), false, false); sq = __uint_as_float(rr[0]) + __uint_as_float(rr[1]); }
                if (fq == 0) ss[(size_t)row * 16 + u.pn * 4 + wc] = sq; }
    }
};
struct EpiGate {
    static constexpr bool PERM = true, AFTER_DRAIN = false;
    const bf16_t* XC; bf16_t* A; bf16_t* U; const float* rb; const float* ib; const float* lam;
    __device__ __forceinline__ void operator()(const f32x4 (&acc)[2][2][4][2], const Unit& u, int wr, int wc, int fr, int fq) const {
        const int row0 = u.pm * BM + wr * 64 + fr; const int ch0 = u.pn * 128 + wc * 32 + 8 * fq;
        f32x4 rb4[2], ib4[2], sp4[2];
#pragma unroll
        for (int n = 0; n < 2; ++n) { rb4[n] = *(GAS const f32x4*)(rb + ch0 + 4 * n); ib4[n] = *(GAS const f32x4*)(ib + ch0 + 4 * n); const f32x4 l4 = *(GAS const f32x4*)(lam + ch0 + 4 * n);
#pragma unroll
            for (int j = 0; j < 4; ++j) sp4[n][j] = -8.f * log1pf(expf(-l4[j])); }
#pragma unroll
        for (int ai = 0; ai < 2; ++ai)
#pragma unroll
            for (int m = 0; m < 4; ++m) { const size_t ro = (size_t)(row0 + ai * HALF + m * 16) * 512 + ch0; const u32x4 xw = *(GAS const u32x4*)(XC + ro);
                float xc[8]; xc[0] = __uint_as_float(xw.x << 16); xc[1] = __uint_as_float(xw.x & 0xffff0000u); xc[2] = __uint_as_float(xw.y << 16); xc[3] = __uint_as_float(xw.y & 0xffff0000u);
                xc[4] = __uint_as_float(xw.z << 16); xc[5] = __uint_as_float(xw.z & 0xffff0000u); xc[6] = __uint_as_float(xw.w << 16); xc[7] = __uint_as_float(xw.w & 0xffff0000u);
                float av[8], uv[8];
#pragma unroll
                for (int n = 0; n < 2; ++n) { const f32x4 rp = acc[ai][0][m][n] + rb4[n], ip = acc[ai][1][m][n] + ib4[n];
#pragma unroll
                    for (int j = 0; j < 4; ++j) { const float r = __builtin_amdgcn_rcpf(1.f + __expf(-rp[j])), ig = __builtin_amdgcn_rcpf(1.f + __expf(-ip[j])); const float la = r * sp4[n][j];
                        const float a = expf(la); av[4 * n + j] = la; uv[4 * n + j] = __builtin_amdgcn_sqrtf(fmaxf(1.f - a * a, 0.f)) * ig * xc[4 * n + j]; } }
                u32x4 wa, wu; wa.x = pk2(av[0], av[1]); wa.y = pk2(av[2], av[3]); wa.z = pk2(av[4], av[5]); wa.w = pk2(av[6], av[7]);
                wu.x = pk2(uv[0], uv[1]); wu.y = pk2(uv[2], uv[3]); wu.z = pk2(uv[4], uv[5]); wu.w = pk2(uv[6], uv[7]);
                *(GAS u32x4*)(A + ro) = wa; *(GAS u32x4*)(U + ro) = wu; }
    }
};
struct EpiQ {
    static constexpr bool PERM = true, AFTER_DRAIN = false;
    bf16_t* Q; const float* cs; const float* sn; float scale;
    __device__ __forceinline__ void operator()(const f32x4 (&acc)[2][2][4][2], const Unit& u, int wr, int wc, int fr, int fq) const {
        const int row0 = u.pm * BM + wr * 64 + fr; const int cb = u.pn * BM + wc * 32;
#pragma unroll
        for (int ai = 0; ai < 2; ++ai)
#pragma unroll
            for (int m = 0; m < 4; ++m) { const int row = row0 + ai * HALF + m * 16; const int t = row % TT; bf16_t* rp = Q + (size_t)row * 1536;
#pragma unroll
                for (int bj = 0; bj < 2; ++bj) { const int c = cb + bj * HALF; f32x4 v0 = acc[ai][bj][m][0], v1 = acc[ai][bj][m][1];
                    if (((c >> 5) % 3) == 2) {
                        const float* cp = cs + t * 16 + 8 * (fq & 1); const float* sp = sn + t * 16 + 8 * (fq & 1);
                        const f32x4 c0 = *(const f32x4*)cp, c1 = *(GAS const f32x4*)(cp + 4), s0 = *(const f32x4*)sp, s1 = *(GAS const f32x4*)(sp + 4);
                        f32x4 o0, o1; const bool upper = (fq >= 2);
#pragma unroll
                        for (int j = 0; j < 4; ++j) {
                            const float a = v0[j], b = v1[j];
                            auto ra = __builtin_amdgcn_permlane32_swap(__float_as_uint(a), __float_as_uint(a), false, false); auto rbb = __builtin_amdgcn_permlane32_swap(__float_as_uint(b), __float_as_uint(b), false, false);
                            const float pa = __uint_as_float(upper ? ra[0] : ra[1]), pb = __uint_as_float(upper ? rbb[0] : rbb[1]);
                            o0[j] = upper ? (a * c0[j] + pa * s0[j]) : (a * c0[j] - pa * s0[j]);
                            o1[j] = upper ? (b * c1[j] + pb * s1[j]) : (b * c1[j] - pb * s1[j]);
                        }
                        v0 = o0; v1 = o1;
                    }
                    v0 = v0 * scale; v1 = v1 * scale; u32x4 w; w.x = pk2(v0[0], v0[1]); w.y = pk2(v0[2], v0[3]); w.z = pk2(v1[0], v1[1]); w.w = pk2(v1[2], v1[3]);
                    *(GAS u32x4*)(rp + c + 8 * fq) = w; } }
    }
};

template <int CTRL> __device__ __forceinline__ f32x2v dpp_ror(f32x2v v) { f32x2v r; const float x0 = v[0], x1 = v[1];
    r[0] = __int_as_float(__builtin_amdgcn_mov_dpp(__float_as_int(x0), CTRL, 0xf, 0xf, true)); r[1] = __int_as_float(__builtin_amdgcn_mov_dpp(__float_as_int(x1), CTRL, 0xf, 0xf, true)); return r; }
struct EpiUp {
    static constexpr bool PERM = true, AFTER_DRAIN = false;
    bf16_t* G; const float* cw; const float* cb; PG8_LAS float* halo; int Mrows; const float* ss;
    __device__ __forceinline__ void operator()(const f32x4 (&acc)[2][2][4][2], const Unit& u, int wr, int wc, int fr, int fq) const {
        const int rb = u.pm * 254 - 2;
        float rs[2][4]; unsigned flags = 0;
#pragma unroll
        for (int ai = 0; ai < 2; ++ai)
#pragma unroll
            for (int m = 0; m < 4; ++m) { const int lrow = 128 * ai + 64 * wr + 16 * m + fr; const int row = rb + lrow; const int rc = row < 0 ? 0 : (row >= Mrows ? Mrows - 1 : row);
                rs[ai][m] = row_rstd(ss, rc, fq); const int t = rc % TT;
                const unsigned f = ((lrow >= 2 && row < Mrows) ? 1u : 0u) | ((t == 0) ? 2u : 0u) | ((t <= 1) ? 4u : 0u); flags |= f << (3 * (ai * 4 + m)); }
        {
            const int t2 = 2 * (((wr * 4 + wc) * 64) + fq * 16 + fr); const int k_ = t2 >> 8, bj_ = (t2 >> 7) & 1, cc_ = t2 & 127;
            const float* src_ = (k_ < 3 ? cw + k_ * 5632 : cb) + bj_ * 2816 + u.pn * 128 + cc_;
            *(PG8_LAS f32x2v*)(halo + 2048 + t2) = *(GAS const f32x2v*)src_; }
        if (fr >= 14) {
#pragma unroll
            for (int ai = 0; ai < 2; ++ai) { PG8_LAS float* hw = halo + ((((2 * ai + wr) * 2 + (fr - 14)) * 4 + wc) * 64) + fq * 4;
#pragma unroll
                for (int bj = 0; bj < 2; ++bj)
#pragma unroll
                    for (int n = 0; n < 2; ++n) *(PG8_LAS f32x4*)(hw + (bj * 2 + n) * 16) = acc[ai][bj][3][n] * rs[ai][3]; }
        }
        asm volatile("s_waitcnt lgkmcnt(0)\n\ts_barrier" ::: "memory");
        const bool bstart = __any((flags & 0xDB6DB6u) != 0u);
        const bool allemit = __all((flags & 0x249249u) == 0x249249u);
        const f32x2v zero = {0.f, 0.f};
#pragma unroll
        for (int nn = 0; nn < 4; ++nn) {
            const int n = nn >> 1, jh = nn & 1;
            const int ca0 = u.pn * 128 + wc * 32 + 8 * fq + 4 * n + 2 * jh;
            PG8_LAS const float* wl = halo + 2048 + wc * 32 + 8 * fq + 4 * n + 2 * jh;
            const f32x2v wA0 = *(PG8_LAS const f32x2v*)(wl), wA1 = *(PG8_LAS const f32x2v*)(wl + 256), wA2 = *(PG8_LAS const f32x2v*)(wl + 512), bA = *(PG8_LAS const f32x2v*)(wl + 768);
            const f32x2v wG0 = *(PG8_LAS const f32x2v*)(wl + 128), wG1 = *(PG8_LAS const f32x2v*)(wl + 256 + 128), wG2 = *(PG8_LAS const f32x2v*)(wl + 512 + 128), bG = *(PG8_LAS const f32x2v*)(wl + 768 + 128);
#pragma unroll
            for (int ai = 0; ai < 2; ++ai) {
                const int s = 2 * ai + wr;
                f32x2v cA1 = zero, cA2 = zero, cG1 = zero, cG2 = zero;
                if (s > 0) { PG8_LAS const float* hr = halo + ((((s - 1) * 2) * 4 + wc) * 64) + fq * 4 + n * 16 + 2 * jh;
                    const f32x2v a2 = *(PG8_LAS const f32x2v*)(hr), a1 = *(PG8_LAS const f32x2v*)(hr + 256), g2 = *(PG8_LAS const f32x2v*)(hr + 32), g1 = *(PG8_LAS const f32x2v*)(hr + 256 + 32);
                    cA1 = a1; cG1 = g1; cA2 = (fr == 0) ? a2 : a1; cG2 = (fr == 0) ? g2 : g1; }
#pragma unroll
                for (int m = 0; m < 4; ++m) {
                    const f32x4 ua4 = acc[ai][0][m][n], ug4 = acc[ai][1][m][n]; const float rsm = rs[ai][m];
                    const f32x2v ua = {ua4[2 * jh] * rsm, ua4[2 * jh + 1] * rsm}, ug = {ug4[2 * jh] * rsm, ug4[2 * jh + 1] * rsm};
                    const f32x2v rA1 = dpp_ror<0x121>(ua), rA2 = dpp_ror<0x122>(ua), rG1 = dpp_ror<0x121>(ug), rG2 = dpp_ror<0x122>(ug);
                    f32x2v pA1 = (fr >= 1) ? rA1 : cA1, pA2 = (fr >= 2) ? rA2 : cA2, pG1 = (fr >= 1) ? rG1 : cG1, pG2 = (fr >= 2) ? rG2 : cG2;
                    const int row = rb + 128 * ai + 64 * wr + 16 * m + fr; const unsigned f = flags >> (3 * (ai * 4 + m));
                    if (bstart) { if (f & 2u) { pA1 = zero; pG1 = zero; }
                                  if (f & 4u) { pA2 = zero; pG2 = zero; } }
                    const f32x2v va = wA0 * pA2 + wA1 * pA1 + wA2 * ua + bA, vg = wG0 * pG2 + wG1 * pG1 + wG2 * ug + bG;
                    const float o0 = va[0] * __builtin_amdgcn_rcpf(1.f + __expf(-va[0])) * vg[0], o1 = va[1] * __builtin_amdgcn_rcpf(1.f + __expf(-va[1])) * vg[1];
                    if (allemit) *(GAS unsigned*)(G + (size_t)row * 2816 + ca0) = pk2(o0, o1);
                    else if (f & 1u) *(GAS unsigned*)(G + (size_t)row * 2816 + ca0) = pk2(o0, o1);
                    cA1 = rA1; cA2 = rA2; cG1 = rG1; cG2 = rG2;
                }
            }
        }
    }
};
struct EpiAny {
    static constexpr bool PERM = true, AFTER_DRAIN = false;
    int kind; void* p0; void* p1; void* p2; const float* f0; const float* f1; const float* f2; int i0, i1, i2; float scale; PG8_LAS float* halo;
    __device__ __forceinline__ void operator()(const f32x4 (&acc)[2][2][4][2], const Unit& u, int wr, int wc, int fr, int fq) const {
        if (kind == 0) { EpiStore<0> e{(bf16_t*)p0, i0, (bf16_t*)p1, i1, i2, f2}; e(acc, u, wr, wc, fr, fq); }
        else if (kind == 1) { EpiStore<1> e{(bf16_t*)p0, i0, (bf16_t*)p0, i0, 1 << 30, nullptr}; e(acc, u, wr, wc, fr, fq); }
        else if (kind == 6) { EpiStore<2> e{(bf16_t*)p0, i0, (bf16_t*)p0, i0, 1 << 30, nullptr}; e(acc, u, wr, wc, fr, fq); }
        else if (kind == 2) { EpiResid e{(bf16_t*)p1, i0, (float*)p2}; e(acc, u, wr, wc, fr, fq); }
        else if (kind == 3) { EpiGate e{(const bf16_t*)p1, (bf16_t*)p0, (bf16_t*)p2, f0, f1, f2}; e(acc, u, wr, wc, fr, fq); }
        else if (kind == 4) { EpiQ e{(bf16_t*)p0, f0, f1, scale}; e(acc, u, wr, wc, fr, fq); }
        else if (kind == 5) { EpiUp e{(bf16_t*)p0, f0, f1, halo, i0, f2}; e(acc, u, wr, wc, fr, fq); }
        else if (kind == 8) {
            int rz = 0; asm volatile("" : "+v"(rz));
            float* T = (float*)p0 + (size_t)u.pm * (256 * 1024); const int c0 = u.pn * BM + wc * 32 + 8 * fq;
#pragma unroll
            for (int ai = 0; ai < 2; ++ai)
#pragma unroll
                for (int m = 0; m < 4; ++m) { float* rp = T + (size_t)(wr * 64 + fr + rz + ai * HALF + m * 16) * 1024 + c0;
#pragma unroll
                    for (int bj = 0; bj < 2; ++bj)
#pragma unroll
                        for (int n = 0; n < 2; ++n) *(GAS f32x4*)(rp + bj * HALF + 4 * n) = acc[ai][bj][m][n]; }
        }
        else { if (acc[0][0][0][0][0] == 123456.789f) *(float*)p0 = 1.f; }
    }
};
template <class Epi, class Sched, bool ALIGN_EPI = false, bool SP2 = false>
__device__ __forceinline__ void gemm_phase(PG8_LAS unsigned char* lds, const Gemm g, const Sched& S, const Epi& E) {
    int tid0 = threadIdx.x; asm volatile("" : "+v"(tid0));
    const int tid = tid0, wid = __builtin_amdgcn_readfirstlane(tid >> 6), lane = tid & 63, wr = wid >> 2, wc = wid & 3, fr = lane & 15, fq = lane >> 4;
    const int K = g.K, nt = K / BK;
    unsigned voffA[2], voffB[2];
#pragma unroll
    for (int i = 0; i < 2; ++i) { int R, C; stage_rc(tid * 16 + i * 8192, R, C); const int Rb = Epi::PERM ? ((R & ~31) + perm32(R & 31)) : R;
        voffA[i] = (unsigned)(R * g.lda + C) * 2u; voffB[i] = (unsigned)(Rb * g.ldb + C) * 2u; }
    const size_t kstep = (size_t)(BK * 2);
    const size_t hstepA = (size_t)HALF * g.lda * 2, hstepB = (size_t)HALF * g.ldb * 2;
    const unsigned ldsw = (unsigned)wid * 1024u;
    const int aoff = lds_byte(wr * 64 + fr, fq * 8), boff = lds_byte(wc * 32 + fr, fq * 8);
#define PG8_SA(b, h) (((b) * 2 + (h)) * HTB)
#define PG8_SB(b, h) ((4 + (b) * 2 + (h)) * HTB)
#define PG8_STAGE(bufoff, gbase, voff) do { _Pragma("unroll") for (int _i = 0; _i < 2; ++_i) \
        __builtin_amdgcn_global_load_lds((const unsigned*)((const char*)(gbase) + (voff)[_i]), (PG8_LAS unsigned*)(lds + (bufoff) + ldsw + _i * 8192), 16, 0, 0); } while (0)
#define PG8_LDA(dst, b, h) do { _Pragma("unroll") for (int m = 0; m < 4; ++m) _Pragma("unroll") for (int k = 0; k < 2; ++k) dst[m][k] = *(const PG8_LAS bf16x8*)(lds + PG8_SA(b, h) + aoff + m * 2048 + k * 1024); } while (0)
#define PG8_LDB(dst, b, h) do { _Pragma("unroll") for (int n = 0; n < 2; ++n) _Pragma("unroll") for (int k = 0; k < 2; ++k) dst[n][k] = *(const PG8_LAS bf16x8*)(lds + PG8_SB(b, h) + boff + n * 2048 + k * 1024); } while (0)
#define PG8_MMA(ai, bj, At, Bt) do { __builtin_amdgcn_s_setprio(1); _Pragma("unroll") for (int m = 0; m < 4; ++m) _Pragma("unroll") for (int n = 0; n < 2; ++n) _Pragma("unroll") for (int k = 0; k < 2; ++k) \
        acc[ai][bj][m][n] = __builtin_amdgcn_mfma_f32_16x16x32_bf16(Bt[n][k], At[m][k], acc[ai][bj][m][n], 0, 0, 0); __builtin_amdgcn_s_setprio(0); } while (0)
#define PG8_WAIT_V(n) asm volatile("s_waitcnt vmcnt(" #n ")" ::: "memory")
#define PG8_WAIT_L(n) asm volatile("s_waitcnt lgkmcnt(" #n ")" ::: "memory")
#define PG8_BAR __builtin_amdgcn_s_barrier()
#define PG8_SCHED __builtin_amdgcn_sched_barrier(0)
    Unit cur, nxt; int ui = 0;
    if (!S.next(0, cur)) return;
    f32x4 acc[2][2][4][2];
#pragma unroll
    for (int a = 0; a < 2; ++a)
#pragma unroll
        for (int b = 0; b < 2; ++b)
#pragma unroll
            for (int m = 0; m < 4; ++m)
#pragma unroll
                for (int n = 0; n < 2; ++n) acc[a][b][m][n] = (f32x4){0.f, 0.f, 0.f, 0.f};
    bf16x8 At[4][2], B0[2][2], B1[2][2];
    const char* cA = (const char*)g.A + (size_t)cur.pm * g.atstep + (size_t)cur.pn * g.a_pn; const char* cB = (const char*)g.Bt + (size_t)cur.pn * g.btstep + (size_t)cur.pm * g.b_pm;
    S.a_ready(cur);
    if constexpr (SP2) {
        PG8_STAGE(PG8_SB(0, 0), cB, voffB); PG8_STAGE(PG8_SB(0, 1), cB + hstepB, voffB); PG8_STAGE(PG8_SA(0, 0), cA, voffA); PG8_STAGE(PG8_SA(0, 1), cA + hstepA, voffA);
        if (wr == 1) PG8_BAR;
        PG8_WAIT_V(2); PG8_BAR;
        PG8_STAGE(PG8_SB(1, 0), cB + kstep, voffB); PG8_STAGE(PG8_SA(1, 0), cA + kstep, voffA); PG8_STAGE(PG8_SB(1, 1), cB + hstepB + kstep, voffB);
        PG8_WAIT_V(6); PG8_BAR;
    } else {
        PG8_STAGE(PG8_SB(0, 0), cB, voffB); PG8_STAGE(PG8_SA(0, 0), cA, voffA); PG8_STAGE(PG8_SB(0, 1), cB + hstepB, voffB); PG8_STAGE(PG8_SA(0, 1), cA + hstepA, voffA);
        if (wr == 1) PG8_BAR;
        PG8_WAIT_V(4); PG8_BAR;
        PG8_STAGE(PG8_SB(1, 0), cB + kstep, voffB); PG8_STAGE(PG8_SA(1, 0), cA + kstep, voffA); PG8_STAGE(PG8_SB(1, 1), cB + hstepB + kstep, voffB);
        PG8_WAIT_V(6); PG8_BAR;
    }
    for (;;) {
        const bool has_next = S.next(ui + 1, nxt);
        const char* nA = has_next ? (const char*)g.A + (size_t)nxt.pm * g.atstep + (size_t)nxt.pn * g.a_pn : cA; const char* nB = has_next ? (const char*)g.Bt + (size_t)nxt.pn * g.btstep + (size_t)nxt.pm * g.b_pm : cB;
        for (int t = 0; t < nt; t += 2) {
            const bool last = (t == nt - 2);
            const char* a1 = cA + (size_t)(t + 1) * kstep;
            const char* a2 = last ? nA : cA + (size_t)(t + 2) * kstep; const char* b2 = last ? nB : cB + (size_t)(t + 2) * kstep;
            const char* a3 = a2 + kstep; const char* b3 = b2 + kstep;
            if (last && has_next) S.a_ready(nxt);
            if constexpr (SP2) {
            PG8_LDB(B0, 0, 0); PG8_LDB(B1, 0, 1); PG8_SCHED; PG8_LDA(At, 0, 0); PG8_STAGE(PG8_SA(1, 1), a1 + hstepA, voffA);
            PG8_WAIT_V(8); PG8_WAIT_L(0); PG8_BAR; PG8_MMA(0, 0, At, B0); PG8_MMA(0, 1, At, B1); PG8_BAR; PG8_SCHED;
            PG8_LDA(At, 0, 1); PG8_STAGE(PG8_SB(0, 0), b2, voffB); PG8_STAGE(PG8_SB(0, 1), b2 + hstepB, voffB); PG8_STAGE(PG8_SA(0, 0), a2, voffA);
            PG8_WAIT_V(8); PG8_WAIT_L(0); PG8_BAR; PG8_MMA(1, 0, At, B0); PG8_MMA(1, 1, At, B1); PG8_BAR; PG8_SCHED;
            PG8_LDB(B0, 1, 0); PG8_LDB(B1, 1, 1); PG8_SCHED; PG8_LDA(At, 1, 0); PG8_STAGE(PG8_SA(0, 1), a2 + hstepA, voffA);
            PG8_WAIT_V(8); PG8_WAIT_L(0); PG8_BAR; PG8_MMA(0, 0, At, B0); PG8_MMA(0, 1, At, B1); PG8_BAR; PG8_SCHED;
            PG8_LDA(At, 1, 1); PG8_STAGE(PG8_SB(1, 0), b3, voffB); PG8_STAGE(PG8_SB(1, 1), b3 + hstepB, voffB); PG8_STAGE(PG8_SA(1, 0), a3, voffA);
            PG8_WAIT_V(8); PG8_WAIT_L(0); PG8_BAR; PG8_MMA(1, 0, At, B0); PG8_MMA(1, 1, At, B1); PG8_BAR; PG8_SCHED;
            } else {
            PG8_LDB(B0, 0, 0); PG8_SCHED; PG8_LDA(At, 0, 0); PG8_STAGE(PG8_SA(1, 1), a1 + hstepA, voffA);
            PG8_WAIT_L(8); PG8_BAR; PG8_WAIT_L(0); PG8_MMA(0, 0, At, B0); PG8_BAR; PG8_SCHED;
            PG8_LDB(B1, 0, 1); PG8_STAGE(PG8_SB(0, 0), b2, voffB);
            PG8_BAR; PG8_WAIT_L(0); PG8_MMA(0, 1, At, B1); PG8_BAR;
            PG8_LDA(At, 0, 1); PG8_STAGE(PG8_SA(0, 0), a2, voffA);
            PG8_BAR; PG8_WAIT_L(0); PG8_MMA(1, 0, At, B0); PG8_BAR; PG8_SCHED;
            PG8_STAGE(PG8_SB(0, 1), b2 + hstepB, voffB);
            PG8_WAIT_V(6); PG8_BAR; PG8_MMA(1, 1, At, B1); PG8_BAR;
            PG8_LDB(B0, 1, 0); PG8_SCHED; PG8_LDA(At, 1, 0); PG8_STAGE(PG8_SA(0, 1), a2 + hstepA, voffA);
            PG8_WAIT_L(8); PG8_BAR; PG8_WAIT_L(0); PG8_MMA(0, 0, At, B0); PG8_BAR; PG8_SCHED;
            PG8_LDB(B1, 1, 1); PG8_STAGE(PG8_SB(1, 0), b3, voffB);
            PG8_BAR; PG8_WAIT_L(0); PG8_MMA(0, 1, At, B1); PG8_BAR;
            PG8_LDA(At, 1, 1); PG8_STAGE(PG8_SA(1, 0), a3, voffA);
            PG8_BAR; PG8_WAIT_L(0); PG8_MMA(1, 0, At, B0); PG8_BAR; PG8_SCHED;
            PG8_STAGE(PG8_SB(1, 1), b3 + hstepB, voffB);
            PG8_WAIT_V(6); PG8_BAR; PG8_MMA(1, 1, At, B1); PG8_BAR;
            }
        }
        if constexpr (ALIGN_EPI) { if (wr == 0) PG8_BAR; }
        if constexpr (!Epi::AFTER_DRAIN) { E(acc, cur, wr, wc, fr, fq); S.done(cur); }
        if (!has_next) break;
#pragma unroll
        for (int a = 0; a < 2; ++a)
#pragma unroll
            for (int b = 0; b < 2; ++b)
#pragma unroll
                for (int m = 0; m < 4; ++m)
#pragma unroll
                    for (int n = 0; n < 2; ++n) acc[a][b][m][n] = (f32x4){0.f, 0.f, 0.f, 0.f};
        cur = nxt; cA = nA; cB = nB; ++ui;
        if constexpr (ALIGN_EPI) { if (wr == 1) PG8_BAR; }
    }
    PG8_WAIT_V(0);
    if constexpr (!ALIGN_EPI) { if (wr == 0) PG8_BAR; }
    PG8_BAR;
    if constexpr (Epi::AFTER_DRAIN) { E.fused(acc, cur, wr, wc, fr, fq, lds, wid, lane); S.done(cur); }
#undef PG8_SA
#undef PG8_SB
#undef PG8_STAGE
#undef PG8_LDA
#undef PG8_LDB
#undef PG8_MMA
#undef PG8_WAIT_V
#undef PG8_WAIT_L
#undef PG8_BAR
#undef PG8_SCHED
}
}
#define DI __device__ __forceinline__
#define LAS __attribute__((address_space(3)))
#define GAS __attribute__((address_space(1)))
using pg8::bf16_t; using pg8::bf16x8; using pg8::f32x4; using pg8::u32x4; using pg8::u32x2; using pg8::pk2; using pg8::f32x2v;
typedef float f32x16 __attribute__((ext_vector_type(16)));
constexpr int TT = pg8::TT, NB = 16, M = NB * TT, DM = 1024, SEQ = 4096;
constexpr int NTILE = M / 256;
constexpr float EPS = 1e-6f;
constexpr size_t MiB = 1u << 20;
constexpr size_t WS_EVIN = 0, WS_EVG = 10 * MiB, WS_EVOUT = 12 * MiB, WS_ODIN = 16 * MiB, WS_UQ = 19 * MiB, WS_UK = 22 * MiB, WS_UV = 23 * MiB, WS_ODOUT = 24 * MiB,
                 WS_UP = 28 * MiB, WS_DOWN = 72 * MiB, WS_COS = 94 * MiB, WS_SIN = 94 * MiB + 512 * 1024, WS_AGG = 95 * MiB, WS_H = 104 * MiB, WS_HB = WS_H + 4096, WS_R = 361 * MiB;
constexpr size_t SZ_EVIN = (size_t)2560 * 1024 * 2, SZ_EVG = (size_t)1024 * 512 * 2, SZ_EVOUT = (size_t)1024 * 1024 * 2, SZ_ODIN = (size_t)768 * 1024 * 2, SZ_UQ = (size_t)1536 * 384 * 2,
                 SZ_UK = (size_t)1024 * 256 * 2, SZ_ODOUT = SZ_EVOUT, SZ_UP = (size_t)5632 * 1024 * 2, SZ_DOWN = (size_t)1024 * 2816 * 2;
constexpr size_t R_U1 = 0, R_GATE = 257 * MiB, R_XC = 322 * MiB, R_Y = 387 * MiB, R_A = 0, R_UU = (size_t)M * 512 * 4;
constexpr size_t R_Q = 0, R_K = 193 * MiB, R_VT = 386 * MiB, R_U2 = R_VT, R_O = 517 * MiB;
constexpr size_t R_G = 0;
constexpr size_t WS_NEED = WS_R + 646 * MiB;
constexpr size_t DO_T = 212 * MiB;
constexpr size_t WS_SS = 97 * MiB;
constexpr size_t DO_HN = 4096, DO_CQN = 129 * MiB, DO_CKVN = 178 * MiB;
constexpr int LDS_BYTES = 131072 + 8192 + 4096;
constexpr int FFN_SPLIT = 129;

struct Params { const float* in[26]; float* out; unsigned char* ws; int ph_lo, ph_hi; };
typedef const __attribute__((address_space(4))) Params* KParams;

DI float bflo(unsigned w) { return __uint_as_float(w << 16); }
DI float bfhi(unsigned w) { return __uint_as_float(w & 0xffff0000u); }
DI void unpack8(const u32x4 w, float* f) { f[0] = bflo(w.x); f[1] = bfhi(w.x); f[2] = bflo(w.y); f[3] = bfhi(w.y); f[4] = bflo(w.z); f[5] = bfhi(w.z); f[6] = bflo(w.w); f[7] = bfhi(w.w); }
DI u32x4 pack8(const float* f) { u32x4 w; w.x = pk2(f[0], f[1]); w.y = pk2(f[2], f[3]); w.z = pk2(f[4], f[5]); w.w = pk2(f[6], f[7]); return w; }
template <int MASK> DI float swz_xor(float v) { return __int_as_float(__builtin_amdgcn_ds_swizzle(__float_as_int(v), (MASK << 10) | 0x1f)); }
DI float half_sum(float v) { auto rr = __builtin_amdgcn_permlane32_swap(__float_as_uint(v), __float_as_uint(v), false, false); return __uint_as_float(rr[0]) + __uint_as_float(rr[1]); }
DI float half_max(float v) { auto rr = __builtin_amdgcn_permlane32_swap(__float_as_uint(v), __float_as_uint(v), false, false); return fmaxf(__uint_as_float(rr[0]), __uint_as_float(rr[1])); }
DI float wave_sum(float v) { v += swz_xor<1>(v); v += swz_xor<2>(v); v += swz_xor<4>(v); v += swz_xor<8>(v); v += swz_xor<16>(v); return half_sum(v); }
DI float bf1(const bf16_t* p) { return __uint_as_float((unsigned)(*(GAS const bf16_t*)p) << 16); }
DI bf16_t tobf(float f) { return (bf16_t)(pk2(f, 0.f) & 0xffffu); }

DI int otid() { int t = threadIdx.x; asm volatile("" : "+v"(t)); return t; }
DI int obid() { int b = blockIdx.x; asm volatile("" : "+s"(b)); return b; }
template <class F> DI void cvt_wT(const float* W, int K, int Ns, bf16_t* Wt, int Nd, F smap, float* sl, const float* gsc = nullptr) {
    const int tid = otid(), tn = Nd / 64, tk = K / 64, total = tn * tk;
    for (int it = obid(); it < total; it += gridDim.x) {
        const int n0 = (it % tn) * 64, k0 = (it / tn) * 64; const int s0 = smap(n0);
        const int j = tid & 63, i = tid >> 6;
        __syncthreads();
#pragma unroll
        for (int r = 0; r < 8; ++r) { const int k = k0 + i * 8 + r; float v = 0.f; if (s0 >= 0 && s0 + j < Ns) v = W[(size_t)k * Ns + s0 + j]; if (gsc) v *= gsc[k]; sl[(i * 8 + r) * 65 + j] = v; }
        __syncthreads();
        const int nl = tid >> 3, kc = tid & 7; float f[8];
#pragma unroll
        for (int e = 0; e < 8; ++e) f[e] = sl[(kc * 8 + e) * 65 + nl];
        *(GAS u32x4*)(Wt + (size_t)(n0 + nl) * K + k0 + kc * 8) = pack8(f);
    }
    __syncthreads();
}
struct MapId { DI int operator()(int n0) const { return n0; } };
struct MapK { DI int operator()(int n0) const { return (n0 >> 6) * 128; } };
struct MapUp { DI int operator()(int n0) const { return ((n0 >> 7) & 1) * 2816 + (n0 >> 8) * 128 + (n0 & 127); } };
struct MapV { DI int operator()(int n0) const { return (n0 >> 6) * 128 + 64; } };

DI void sincos_r(float ang, float& c, float& s) {
    const float n = rintf(ang * 0.15915494309189535f);
    float r = fmaf(-n, 6.28125f, ang); r = fmaf(-n, 1.9353071795864769e-3f, r);
    c = __cosf(r); s = __sinf(r);
}
DI void phase_prologue(KParams P, float* sl) {
    unsigned char* ws = P->ws;
    for (int j = 0; j < 2; ++j) {
        cvt_wT(P->in[3] + (size_t)j * 1024 * 2560, 1024, 2560, (bf16_t*)(ws + WS_EVIN + j * SZ_EVIN), 2560, MapId(), sl, P->in[2] + j * 1024);
        cvt_wT(P->in[12] + (size_t)j * 1024 * 1024, 1024, 1024, (bf16_t*)(ws + WS_EVOUT + j * SZ_EVOUT), 1024, MapId(), sl);
        cvt_wT(P->in[14] + (size_t)j * 1024 * 672, 1024, 672, (bf16_t*)(ws + WS_ODIN + j * SZ_ODIN), 768, MapId(), sl, P->in[13] + j * 1024);
        cvt_wT(P->in[17] + (size_t)j * 384 * 1536, 384, 1536, (bf16_t*)(ws + WS_UQ + j * SZ_UQ), 1536, MapId(), sl);
        cvt_wT(P->in[18] + (size_t)j * 256 * 2048, 256, 2048, (bf16_t*)(ws + WS_UK + j * SZ_UK), 1024, MapK(), sl);
        cvt_wT(P->in[18] + (size_t)j * 256 * 2048, 256, 2048, (bf16_t*)(ws + WS_UV + j * SZ_UK), 1024, MapV(), sl);
        cvt_wT(P->in[19] + (size_t)j * 1024 * 1024, 1024, 1024, (bf16_t*)(ws + WS_ODOUT + j * SZ_ODOUT), 1024, MapId(), sl);
    }
    for (int l = 0; l < 4; ++l) {
        cvt_wT(P->in[21] + (size_t)l * 1024 * 5632, 1024, 5632, (bf16_t*)(ws + WS_UP + l * SZ_UP), 5632, MapUp(), sl, P->in[20] + l * 1024);
        cvt_wT(P->in[24] + (size_t)l * 2816 * 1024, 2816, 1024, (bf16_t*)(ws + WS_DOWN + l * SZ_DOWN), 1024, MapId(), sl);
    }
    const int gtid = obid() * 512 + otid(), nth = gridDim.x * 512;
    for (int idx = gtid; idx < 2 * 1024 * 64; idx += nth) {
        const int j = idx >> 16, rem = idx & 65535, n = rem >> 6, k0 = (rem & 63) * 8;
        const int pn = n >> 8, bj = (n >> 7) & 1, ch = pn * 128 + (n & 127), h = ch >> 6, jj = ch & 63;
        const float* src = (bj ? P->in[9] : P->in[7]) + (size_t)(j * 8 + h) * 4096;
        float f[8];
#pragma unroll
        for (int e = 0; e < 8; ++e) { const int k = k0 + e; f[e] = ((k >> 6) == h) ? src[(k & 63) * 64 + jj] : 0.f; }
        *(GAS u32x4*)((bf16_t*)(ws + WS_EVG + j * SZ_EVG) + (size_t)n * 512 + k0) = pack8(f);
    }
    { bf16_t* HB = (bf16_t*)(ws + WS_HB); float* ss0 = (float*)(ws + WS_SS);
      const int lane = otid() & 63, gw = obid() * 8 + (otid() >> 6), nw = gridDim.x * 8;
      for (int row = gw; row < M; row += nw) {
          const int b = row / TT, t = row % TT;
          GAS const f32x4* src = (GAS const f32x4*)((t < 16) ? P->in[1] + (size_t)t * 1024 : P->in[0] + ((size_t)b * SEQ + (t - 16)) * 1024);
          GAS u32x2* bp = (GAS u32x2*)(HB + (size_t)row * 1024); float sq = 0.f;
#pragma unroll
          for (int i = 0; i < 4; ++i) { const f32x4 v = src[lane + 64 * i]; u32x2 w; w.x = pk2(v[0], v[1]); w.y = pk2(v[2], v[3]); bp[lane + 64 * i] = w;
              sq += (v[0] * v[0] + v[1] * v[1]) + (v[2] * v[2] + v[3] * v[3]); }
          sq = wave_sum(sq); if (lane < 16) ss0[(size_t)row * 16 + lane] = (lane == 0) ? sq : 0.f;
      } }
    float* cs = (float*)(ws + WS_COS); float* sn = (float*)(ws + WS_SIN);
    for (int idx = gtid; idx < TT * 16; idx += nth) {
        const int t = idx >> 4, i = idx & 15;
        const float bb = ((i & 3) == 0) ? 1.0f : ((i & 3) == 1) ? 0.5623413251903491f : ((i & 3) == 2) ? 0.31622776601683794f : 0.1778279410038923f;
        const int e = i >> 2; const float sc = (e == 0) ? 1.0f : (e == 1) ? 0.1f : (e == 2) ? 0.01f : 0.001f;
        const float inv = bb * sc; const float ang = (float)t * inv;
        float c, s; sincos_r(ang, c, s); cs[idx] = c; sn[idx] = s;
    }
}

DI void phase_final(const bf16_t* HB, const float* g, float* out) {
    const int lane = otid() & 63, gw = obid() * 8 + (otid() >> 6), nw = gridDim.x * 8;
    f32x4 g4[4];
#pragma unroll
    for (int i = 0; i < 4; ++i) g4[i] = ((const f32x4*)g)[lane + 64 * i];
    for (int r = gw; r < NB * SEQ; r += nw) {
        const int b = r >> 12, s = r & 4095; const int row = b * TT + 16 + s;
        GAS const u32x2* p = (GAS const u32x2*)(HB + (size_t)row * 1024); f32x4 v[4]; float ss = 0.f;
#pragma unroll
        for (int i = 0; i < 4; ++i) { const u32x2 w = p[lane + 64 * i]; v[i][0] = bflo(w.x); v[i][1] = bfhi(w.x); v[i][2] = bflo(w.y); v[i][3] = bfhi(w.y);
            ss += (v[i][0] * v[i][0] + v[i][1] * v[i][1]) + (v[i][2] * v[i][2] + v[i][3] * v[i][3]); }
        const float rstd = rsqrtf(wave_sum(ss) * (1.f / 1024) + EPS);
        GAS f32x4* o = (GAS f32x4*)(out + (size_t)r * 1024);
#pragma unroll
        for (int i = 0; i < 4; ++i) o[lane + 64 * i] = v[i] * rstd * g4[i];
    }
}

DI void phase_evconv(const bf16_t* U1, const float* ca, const float* cb, const float* cbias, bf16_t* Y, bf16_t* XC) {
    const int lane = otid() & 63, gw = obid() * 8 + (otid() >> 6), nw = gridDim.x * 8; const int c8 = lane * 8;
    float wa[3][8], wb[4][8], bs[8];
#pragma unroll
    for (int k = 0; k < 3; ++k)
#pragma unroll
        for (int e = 0; e < 8; ++e) wa[k][e] = ca[k * 512 + c8 + e];
#pragma unroll
    for (int k = 0; k < 4; ++k)
#pragma unroll
        for (int e = 0; e < 8; ++e) wb[k][e] = cb[k * 512 + c8 + e];
#pragma unroll
    for (int e = 0; e < 8; ++e) bs[e] = cbias[c8 + e];
    for (int ri = M / 16 - 1 - gw; ri >= 0; ri -= nw) {
        const int r0 = ri * 16, t0 = r0 % TT;
        float p1[8], p2[8], x1[8], x2[8], x3[8];
#pragma unroll
        for (int e = 0; e < 8; ++e) { p1[e] = p2[e] = x1[e] = x2[e] = x3[e] = 0.f; }
        if (t0 != 0) {
            float a[8], b[8];
            const bf16_t* q1 = U1 + (size_t)(r0 - 1) * 2048 + c8; const bf16_t* q2 = U1 + (size_t)(r0 - 2) * 2048 + c8; const bf16_t* q3 = U1 + (size_t)(r0 - 3) * 2048 + c8;
            unpack8(*(GAS const u32x4*)(q1 + 512), a); unpack8(*(GAS const u32x4*)(q1 + 1024), b);
#pragma unroll
            for (int e = 0; e < 8; ++e) p1[e] = a[e] * b[e];
            unpack8(*(GAS const u32x4*)(q2 + 512), a); unpack8(*(GAS const u32x4*)(q2 + 1024), b);
#pragma unroll
            for (int e = 0; e < 8; ++e) p2[e] = a[e] * b[e];
            unpack8(*(GAS const u32x4*)(q1 + 1536), x1); unpack8(*(GAS const u32x4*)(q2 + 1536), x2); unpack8(*(GAS const u32x4*)(q3 + 1536), x3);
        }
        for (int rr = 0; rr < 16; ++rr) {
            const size_t row = (size_t)(r0 + rr); const bf16_t* q = U1 + row * 2048 + c8;
            float gb[8], gc[8], xa[8], x0[8], p0[8], ya[8], xc[8];
            unpack8(*(GAS const u32x4*)(q), gb); unpack8(*(GAS const u32x4*)(q + 512), gc); unpack8(*(GAS const u32x4*)(q + 1024), xa); unpack8(*(GAS const u32x4*)(q + 1536), x0);
#pragma unroll
            for (int e = 0; e < 8; ++e) {
                p0[e] = gc[e] * xa[e];
                ya[e] = gb[e] * (wa[0][e] * p2[e] + wa[1][e] * p1[e] + wa[2][e] * p0[e]);
                xc[e] = wb[0][e] * x3[e] + wb[1][e] * x2[e] + wb[2][e] * x1[e] + wb[3][e] * x0[e] + bs[e];
                p2[e] = p1[e]; p1[e] = p0[e]; x3[e] = x2[e]; x2[e] = x1[e]; x1[e] = x0[e];
            }
            *(GAS u32x4*)(Y + row * 1024 + c8) = pack8(ya); *(GAS u32x4*)(XC + row * 512 + c8) = pack8(xc);
        }
    }
}

DI void phase_scan1(const bf16_t* A, const bf16_t* U, float* agg) {
    const int ch = otid();
    for (int it = obid(); it < 256; it += gridDim.x) {
        const int b = it >> 4, c = it & 15; const size_t base = ((size_t)b * TT + (size_t)c * 257) * 512 + ch;
        float Pl = 0.f, S = 0.f;
        for (int s0 = 0; s0 < 256; s0 += 8) {
            float a[8], u[8];
#pragma unroll
            for (int e = 0; e < 8; ++e) { a[e] = bf1(A + base + (size_t)(s0 + e) * 512); u[e] = bf1(U + base + (size_t)(s0 + e) * 512); }
#pragma unroll
            for (int e = 0; e < 8; ++e) { S = __expf(a[e]) * S + u[e]; Pl += a[e]; }
        }
        { const float a = bf1(A + base + (size_t)256 * 512), u = bf1(U + base + (size_t)256 * 512); S = __expf(a) * S + u; Pl += a; }
        agg[((size_t)it * 512 + ch) * 2] = __expf(Pl); agg[((size_t)it * 512 + ch) * 2 + 1] = S;
    }
}
DI float gelu_tanh(float x) { const float u = 0.7978845608028654f * (x + 0.044715f * x * x * x); const float e = __expf(2.f * u); const float th = 1.f - 2.f / (e + 1.f); return 0.5f * x * (1.f + th); }
DI void phase_scan2(const bf16_t* A, const bf16_t* U, const float* agg, const bf16_t* GATE, bf16_t* Y) {
    const int ch = otid();
    for (int it = obid(); it < 256; it += gridDim.x) {
        const int b = it >> 4, c = it & 15; const size_t row0 = (size_t)b * TT + (size_t)c * 257; const size_t base = row0 * 512 + ch;
        float h = 0.f;
        for (int cc = 0; cc < c; ++cc) { const float Pp = agg[((size_t)(b * 16 + cc) * 512 + ch) * 2], S = agg[((size_t)(b * 16 + cc) * 512 + ch) * 2 + 1]; h = Pp * h + S; }
        for (int s0 = 0; s0 < 256; s0 += 8) {
            float a[8], u[8], g[8];
#pragma unroll
            for (int e = 0; e < 8; ++e) { a[e] = bf1(A + base + (size_t)(s0 + e) * 512); u[e] = bf1(U + base + (size_t)(s0 + e) * 512); g[e] = bf1(GATE + base + (size_t)(s0 + e) * 512); }
#pragma unroll
            for (int e = 0; e < 8; ++e) { h = __expf(a[e]) * h + u[e]; Y[(row0 + s0 + e) * 1024 + 512 + ch] = tobf(gelu_tanh(g[e]) * h); }
        }
        { const float a = bf1(A + base + (size_t)256 * 512), u = bf1(U + base + (size_t)256 * 512), g = bf1(GATE + base + (size_t)256 * 512); h = __expf(a) * h + u; Y[(row0 + 256) * 1024 + 512 + ch] = tobf(gelu_tanh(g) * h); }
    }
}

DI void phase_oddnorm(const bf16_t* U2, const float* qn, const float* kvn, const float* cs, const float* sn, bf16_t* CQN, bf16_t* CKVN, bf16_t* K) {
    const int lane = otid() & 63, gw = obid() * 8 + (otid() >> 6), nw = gridDim.x * 8;
    float gq[6], gk[4];
#pragma unroll
    for (int e = 0; e < 6; ++e) gq[e] = qn[lane * 6 + e];
#pragma unroll
    for (int e = 0; e < 4; ++e) gk[e] = kvn[lane * 4 + e];
    for (int row = gw; row < M; row += nw) {
        const bf16_t* u = U2 + (size_t)row * 768; const int t = row % TT;
        GAS const unsigned* uq = (GAS const unsigned*)(u + lane * 6); const unsigned w0 = uq[0], w1 = uq[1], w2 = uq[2];
        float q[6] = {bflo(w0), bfhi(w0), bflo(w1), bfhi(w1), bflo(w2), bfhi(w2)};
        float ss = 0.f;
#pragma unroll
        for (int e = 0; e < 6; ++e) ss += q[e] * q[e];
        const float rq = rsqrtf(wave_sum(ss) * (1.f / 384) + EPS);
        GAS unsigned* oq = (GAS unsigned*)(CQN + (size_t)row * 384 + lane * 6);
        oq[0] = pk2(q[0] * rq * gq[0], q[1] * rq * gq[1]); oq[1] = pk2(q[2] * rq * gq[2], q[3] * rq * gq[3]); oq[2] = pk2(q[4] * rq * gq[4], q[5] * rq * gq[5]);
        const u32x2 kw = *(GAS const u32x2*)(u + 384 + lane * 4);
        float kv[4] = {bflo(kw.x), bfhi(kw.x), bflo(kw.y), bfhi(kw.y)};
        float s2 = (kv[0] * kv[0] + kv[1] * kv[1]) + (kv[2] * kv[2] + kv[3] * kv[3]);
        const float rk = rsqrtf(wave_sum(s2) * (1.f / 256) + EPS);
        u32x2 ow; ow.x = pk2(kv[0] * rk * gk[0], kv[1] * rk * gk[1]); ow.y = pk2(kv[2] * rk * gk[2], kv[3] * rk * gk[3]);
        *(GAS u32x2*)(CKVN + (size_t)row * 256 + lane * 4) = ow;
        const float x = bf1(u + 640 + (lane & 31)); const float xp = swz_xor<16>(x);
        const float c = cs[t * 16 + (lane & 15)], s = sn[t * 16 + (lane & 15)];
        const float o = (lane & 16) ? (x * c + xp * s) : (x * c - xp * s);
        const bf16_t ob = tobf(o);
        if (lane < 32) {
            const int b_ = row / TT; bf16_t* kp = K + ((size_t)(b_ * 16) * TT + t) * 96 + 64 + lane;
#pragma unroll
            for (int h = 0; h < 16; ++h) kp[(size_t)h * TT * 96] = ob;
        }
    }
}

constexpr int KPITCH = 208, VPITCH = 144, KBUF = 64 * KPITCH, VBUF = 64 * VPITCH;
DI f32x16 mfma32(bf16x8 a, bf16x8 b, f32x16 c) { return __builtin_amdgcn_mfma_f32_32x32x16_bf16(a, b, c, 0, 0, 0); }
template <int VAR> DI void phase_attn(LAS unsigned char* lds, const bf16_t* Q, const bf16_t* K, const bf16_t* VT, bf16_t* O) {
    const int tid = otid(), lane = tid & 63, r32 = lane & 31, hi = lane >> 5; const int wid = __builtin_amdgcn_readfirstlane(tid >> 6);
    LAS unsigned char* kbuf = lds; LAS unsigned char* vbuf = lds + 2 * KBUF;
    const int krow0 = tid / 12, kch0 = tid % 12; const int id1 = tid + 512; const int krow1 = id1 / 12, kch1 = id1 % 12; const bool k2 = id1 < 768;
    const int vd = tid >> 3, vch = tid & 7;
    const int bid_ = obid(); const bool latin = (gridDim.x == 256);
    const int nsteps = latin ? 17 : (17 * 256 - bid_ + (int)gridDim.x - 1) / (int)gridDim.x;
    for (int st = 0; st < nsteps; ++st) {
        int qb, bh;
        if (latin) { const int x = bid_ & 7, li = bid_ >> 3, g = li >> 4, i = li & 15; const int base = x * 32 + g * 16;
            if (st < 16) { bh = base + st; qb = (i + st) % 17; } else { bh = base + i; qb = (i + 16) % 17; } }
        else { const int u = bid_ + st * (int)gridDim.x; qb = 16 - (u >> 8); bh = u & 255; }
        const int b = bh >> 4, h = bh & 15; const int q0 = qb * 256;
        const size_t rowb = (size_t)b * TT;
        const int qlast = (q0 + 255 < TT - 1) ? q0 + 255 : TT - 1; const int ntiles = (qlast >> 6) + 1;
        const int qw0 = q0 + 32 * wid; const bool wvalid = qw0 < TT;
        int my_last = (qw0 + 31) >> 6; if (my_last > ntiles - 1) my_last = ntiles - 1; if (!wvalid) my_last = -1;
        int tq = qw0 + r32; if (tq > TT - 1) tq = TT - 1;
        bf16x8 qr[6];
        { const bf16_t* qp = Q + (rowb + tq) * 1536 + h * 96 + 8 * hi;
#pragma unroll
          for (int s = 0; s < 6; ++s) qr[s] = *(GAS const bf16x8*)(qp + 16 * s); }
        const bf16_t* Kh = K + (size_t)bh * TT * 96; const bf16_t* Vh = VT + (size_t)(bh * 64 + vd) * 4160;
        u32x4 kr0, kr1 = {0u, 0u, 0u, 0u}, vr;
#define ATT_LOAD(j) do { int ra = 64 * (j) + krow0; if (ra > TT - 1) ra = TT - 1; kr0 = *(GAS const u32x4*)(Kh + (size_t)ra * 96 + kch0 * 8); \
            if (k2) { int rb = 64 * (j) + krow1; if (rb > TT - 1) rb = TT - 1; kr1 = *(GAS const u32x4*)(Kh + (size_t)rb * 96 + kch1 * 8); } \
            vr = *(GAS const u32x4*)(Vh + 64 * (j) + vch * 8); } while (0)
#define ATT_STORE(bufi) do { *(LAS u32x4*)(kbuf + (bufi) * KBUF + krow0 * KPITCH + kch0 * 16) = kr0; if (k2) *(LAS u32x4*)(kbuf + (bufi) * KBUF + krow1 * KPITCH + kch1 * 16) = kr1; \
            { LAS unsigned char* vp_ = vbuf + (bufi) * VBUF + vd * VPITCH + (vch >> 1) * 32 + (vch & 1) * 8; u32x2 lo_ = {vr.x, vr.y}, hi_ = {vr.z, vr.w}; *(LAS u32x2*)vp_ = lo_; *(LAS u32x2*)(vp_ + 16) = hi_; } } while (0)
        ATT_LOAD(0); ATT_STORE(0);
        __syncthreads();
        float mrun = 0.f, lrun = 0.f; f32x16 o0, o1;
#pragma unroll
        for (int r = 0; r < 16; ++r) { o0[r] = 0.f; o1[r] = 0.f; }
        for (int j = 0; j < ntiles; ++j) {
            const int buf = j & 1;
            if (VAR != 3 && j + 1 < ntiles) ATT_LOAD(j + 1);
            if (VAR != 4 && j <= my_last) {
                LAS const unsigned char* kb = kbuf + buf * KBUF + r32 * KPITCH + 16 * hi; LAS const unsigned char* vb = vbuf + buf * VBUF + r32 * VPITCH + 16 * hi;
                f32x16 p0, p1;
#pragma unroll
                for (int r = 0; r < 16; ++r) { p0[r] = -mrun; p1[r] = -mrun; }
                bf16x8 ka[12], va[8];
#pragma unroll
                for (int s = 0; s < 6; ++s) { ka[2 * s] = *(LAS const bf16x8*)(kb + 32 * s); ka[2 * s + 1] = *(LAS const bf16x8*)(kb + 32 * KPITCH + 32 * s); }
#pragma unroll
                for (int f = 0; f < 4; ++f) { va[2 * f] = *(LAS const bf16x8*)(vb + 32 * f); va[2 * f + 1] = *(LAS const bf16x8*)(vb + 32 * VPITCH + 32 * f); }
                __builtin_amdgcn_sched_barrier(0);
#pragma unroll
                for (int s = 0; s < 6; ++s) { if (VAR == 2) { p0[s] += __builtin_bit_cast(f32x4, ka[2 * s])[0]; p1[s] += __builtin_bit_cast(f32x4, ka[2 * s + 1])[1]; } else { p0 = mfma32(ka[2 * s], qr[s], p0); p1 = mfma32(ka[2 * s + 1], qr[s], p1); } }
                if (64 * j + 63 > qw0) {
                    const int qa = qw0 + r32, kb0 = 64 * j + 4 * hi;
#pragma unroll
                    for (int r = 0; r < 16; ++r) { const int kv = kb0 + (r & 3) + 8 * (r >> 2); if (kv > qa) p0[r] = -INFINITY; if (kv + 32 > qa) p1[r] = -INFINITY; }
                }
                float mx;
                { float a_ = __builtin_fmaxf(__builtin_fmaxf(p0[0], p0[1]), p1[0]), b_ = __builtin_fmaxf(__builtin_fmaxf(p0[2], p0[3]), p1[1]); a_ = __builtin_fmaxf(__builtin_fmaxf(a_, p1[2]), p1[3]);
#pragma unroll
                  for (int r = 4; r < 16; r += 4) { a_ = __builtin_fmaxf(__builtin_fmaxf(a_, p0[r]), p0[r + 1]); b_ = __builtin_fmaxf(__builtin_fmaxf(b_, p0[r + 2]), p0[r + 3]);
                      a_ = __builtin_fmaxf(__builtin_fmaxf(a_, p1[r]), p1[r + 1]); b_ = __builtin_fmaxf(__builtin_fmaxf(b_, p1[r + 2]), p1[r + 3]); }
                  mx = half_max(__builtin_fmaxf(a_, b_)); }
                if (j == 0) {
                    mrun = mx;
#pragma unroll
                    for (int r = 0; r < 16; ++r) { p0[r] -= mx; p1[r] -= mx; }
                } else if (__any(mx > 0.f)) {
                    const float dl = __builtin_fmaxf(mx, 0.f); mrun += dl; const float fsc = __builtin_amdgcn_exp2f(-dl); lrun *= fsc;
#pragma unroll
                    for (int r = 0; r < 16; ++r) { p0[r] -= dl; p1[r] -= dl; o0[r] *= fsc; o1[r] *= fsc; }
                }
                float ls = 0.f;
#pragma unroll
                for (int r = 0; r < 16; ++r) { if (VAR != 1) { p0[r] = __builtin_amdgcn_exp2f(p0[r]); p1[r] = __builtin_amdgcn_exp2f(p1[r]); } }
#pragma unroll
                for (int r = 0; r < 16; r += 2) ls += (p0[r] + p0[r + 1]) + (p1[r] + p1[r + 1]);
                lrun += ls;
                bf16x8 pf[4];
                { u32x4 w;
                  w.x = pk2(p0[0], p0[1]); w.y = pk2(p0[2], p0[3]); w.z = pk2(p0[4], p0[5]); w.w = pk2(p0[6], p0[7]); pf[0] = __builtin_bit_cast(bf16x8, w);
                  w.x = pk2(p0[8], p0[9]); w.y = pk2(p0[10], p0[11]); w.z = pk2(p0[12], p0[13]); w.w = pk2(p0[14], p0[15]); pf[1] = __builtin_bit_cast(bf16x8, w);
                  w.x = pk2(p1[0], p1[1]); w.y = pk2(p1[2], p1[3]); w.z = pk2(p1[4], p1[5]); w.w = pk2(p1[6], p1[7]); pf[2] = __builtin_bit_cast(bf16x8, w);
                  w.x = pk2(p1[8], p1[9]); w.y = pk2(p1[10], p1[11]); w.z = pk2(p1[12], p1[13]); w.w = pk2(p1[14], p1[15]); pf[3] = __builtin_bit_cast(bf16x8, w); }
#pragma unroll
                for (int f = 0; f < 4; ++f) { if (VAR == 2) { o0[f] += __builtin_bit_cast(f32x4, va[2 * f])[0] * __builtin_bit_cast(f32x4, pf[f])[1]; o1[f] += __builtin_bit_cast(f32x4, va[2 * f + 1])[2]; } else { o0 = mfma32(va[2 * f], pf[f], o0); o1 = mfma32(va[2 * f + 1], pf[f], o1); } }
            }
            if (VAR != 3 && j + 1 < ntiles) ATT_STORE(buf ^ 1);
            __syncthreads();
        }
        const float lt = half_sum(lrun);
        if (qw0 + r32 < TT) {
            const float inv = 1.f / lt; bf16_t* op = O + (rowb + qw0 + r32) * 1024 + h * 64 + 4 * hi;
#pragma unroll
            for (int g = 0; g < 4; ++g) {
                u32x2 w; w.x = pk2(o0[4 * g] * inv, o0[4 * g + 1] * inv); w.y = pk2(o0[4 * g + 2] * inv, o0[4 * g + 3] * inv); *(GAS u32x2*)(op + 8 * g) = w;
                w.x = pk2(o1[4 * g] * inv, o1[4 * g + 1] * inv); w.y = pk2(o1[4 * g + 2] * inv, o1[4 * g + 3] * inv); *(GAS u32x2*)(op + 32 + 8 * g) = w;
            }
        }
    }
#undef ATT_LOAD
#undef ATT_STORE
}

DI void phase_tailfin(bf16_t* HB, const float* T, int nsl, float* ss, LAS float* sl) {
    const int tid = otid(), lane = tid & 63, wid = tid >> 6;
    for (int r = obid(); r < 256; r += gridDim.x) {
        const size_t row = 65536 + r; GAS unsigned* hp = (GAS unsigned*)(HB + row * 1024) + tid; GAS const f32x2v* tp = (GAS const f32x2v*)(T + (size_t)r * 1024) + tid;
        const unsigned h = *hp; float v0 = bflo(h), v1 = bfhi(h);
        float t0 = 0.f, t1 = 0.f;
        for (int s = 0; s < nsl; ++s) { const f32x2v t = tp[(size_t)s * (256 * 512)]; t0 += t[0]; t1 += t[1]; }
        v0 += t0; v1 += t1;
        *hp = pk2(v0, v1);
        const float sq = wave_sum(v0 * v0 + v1 * v1);
        __syncthreads();
        if (lane == 0) sl[wid] = sq;
        __syncthreads();
        if (tid < 16) { float tot = 0.f; if (tid == 0) { for (int w = 0; w < 8; ++w) tot += sl[w]; } *(GAS float*)(ss + row * 16 + tid) = tot; }
    }
    __syncthreads();
}

constexpr int N_PHASES = 1 + 2 * 10 + 2 * 11 + 1;
#ifndef PG8_SP2_FLAG
#define PG8_SP2_FLAG true
#endif
#ifndef PROBE_MASK
#define PROBE_MASK 0
#endif
constexpr size_t WS_BAR = 96 * MiB;
DI void grid_bar(unsigned* w) {
    asm volatile("s_waitcnt vmcnt(0)" ::: "memory");
    __syncthreads();
    if (threadIdx.x == 0) {
        __builtin_amdgcn_fence(__ATOMIC_RELEASE, "agent");
        asm volatile("s_waitcnt vmcnt(0)" ::: "memory");
        const unsigned g = blockIdx.x & 7u, ng = gridDim.x >> 3, lg = 31u - (unsigned)__builtin_clz(ng);
        const unsigned old = __hip_atomic_fetch_add(w + 64 * g, 1u, __ATOMIC_RELAXED, __HIP_MEMORY_SCOPE_AGENT);
        const unsigned gen = old >> lg;
        if ((old & (ng - 1u)) == ng - 1u) {
            const unsigned o2 = __hip_atomic_fetch_add(w + 64 * 16, 1u, __ATOMIC_RELAXED, __HIP_MEMORY_SCOPE_AGENT);
            if ((o2 & 7u) == 7u) {
#pragma unroll
                for (int j = 0; j < 8; ++j) (void)__hip_atomic_fetch_add(w + 64 * (8 + j), 1u, __ATOMIC_RELAXED, __HIP_MEMORY_SCOPE_AGENT);
            }
        }
        while (__hip_atomic_load(w + 64 * (8 + g), __ATOMIC_RELAXED, __HIP_MEMORY_SCOPE_AGENT) <= gen) __builtin_amdgcn_s_sleep(1);
        __builtin_amdgcn_fence(__ATOMIC_ACQUIRE, "agent");
        asm volatile("s_waitcnt vmcnt(0)" ::: "memory");
    }
    __syncthreads();
}
DI int probe_reps(int ph) {
    if (PROBE_MASK == 0) return 1;
    if (ph == 0 || ph == N_PHASES - 1) return ((PROBE_MASK >> 12) & 1) ? 2 : 1;
    int layer = 0, r = ph - 1;
    if (r >= 31) { layer = 3; r -= 31; } else if (r >= 21) { layer = 2; r -= 21; } else if (r >= 10) { layer = 1; r -= 10; }
    const int nmix = (layer & 1) ? 8 : 7; int kind = 0;
    if (r < nmix) { if ((layer & 1) == 0) { const int k[7] = {9, 2, 10, 3, 4, 0, 14}; kind = k[r]; } else { const int k[8] = {9, 5, 11, 11, 11, 6, 0, 14}; kind = k[r]; } }
    else { r -= nmix; kind = (r == 0) ? 8 : (r == 1) ? 0 : 14; }
#ifdef PROBE_RESID
    if (kind == 0 && ph != 0 && ph != N_PHASES - 1) { int l2 = 0, r2 = ph - 1; if (r2 >= 25) { l2 = 3; r2 -= 25; } else if (r2 >= 17) { l2 = 2; r2 -= 17; } else if (r2 >= 8) { l2 = 1; r2 -= 8; } const int nm2 = (l2 & 1) ? 7 : 6; if (r2 == nm2 - 1 || r2 == nm2 + 1) return 2; }
#endif
    if (((PROBE_MASK >> 13) & 1) && (kind == 8 || kind == 9 || kind == 10 || kind == 11 || kind == 0)) return 2;
    return ((PROBE_MASK >> kind) & 1) ? 2 : 1;
}
__global__ void __launch_bounds__(512, 2) mega(Params Pkarg) {
    extern __shared__ __attribute__((aligned(16))) unsigned char smem[];
    cg::grid_group grid = cg::this_grid();
    LAS unsigned char* lds = (LAS unsigned char*)smem;
    const int lo = Pkarg.ph_lo, hi = Pkarg.ph_hi;
    unsigned* barw = (unsigned*)(Pkarg.ws + WS_BAR);
    if (blockIdx.x == 0 && threadIdx.x < 17) __hip_atomic_store(barw + 64 * threadIdx.x, 0u, __ATOMIC_RELAXED, __HIP_MEMORY_SCOPE_AGENT);
    for (int ph = lo; ph < hi; ++ph) {
        int kz = 0; asm volatile("" : "+s"(kz));
        KParams P = (KParams)((const __attribute__((address_space(4))) char*)__builtin_amdgcn_kernarg_segment_ptr() + kz);
        unsigned char* ws = P->ws; unsigned char* dob = (unsigned char*)P->out;
        asm volatile("" : "+s"(ws), "+s"(dob));
        const float* cs = (const float*)(ws + WS_COS); const float* sn = (const float*)(ws + WS_SIN);
        unsigned char* R = ws + WS_R;
        bool do_sync = true;
        for (int rep = probe_reps(ph); rep > 0; --rep) {
        int layer = 0, r = ph - 1;
        if (ph == 0) { phase_prologue(P, (float*)smem); }
        else if (ph == N_PHASES - 1) { phase_final((const bf16_t*)(ws + WS_HB), P->in[25], P->out); }
        else {
            if (r >= 31) { layer = 3; r -= 31; } else if (r >= 21) { layer = 2; r -= 21; } else if (r >= 10) { layer = 1; r -= 10; }
            const int j = layer >> 1; const int nmix = (layer & 1) ? 8 : 7;
            int gk = -1; const bf16_t* gA = nullptr; const void* gB = nullptr; int gM = 0, gN = 0, gK = 0, gld = 0; size_t gAt = 0, gBt = 0, gApn = 0;
            pg8::EpiAny E{}; E.i2 = 1 << 30;
            bf16_t* HB = (bf16_t*)(ws + WS_HB); float* SS0 = (float*)(ws + WS_SS); float* SS1 = SS0; float* tf_ss = nullptr; int tf_n = 0;
            bf16_t* U1 = (bf16_t*)(R + R_U1); bf16_t* GATE = (bf16_t*)(R + R_GATE); bf16_t* XC = (bf16_t*)(R + R_XC); bf16_t* Y = (bf16_t*)(R + R_Y);
            bf16_t* A = (bf16_t*)(R + R_A); bf16_t* UU = (bf16_t*)(R + R_UU); float* agg = (float*)(ws + WS_AGG);
            bf16_t* U2 = (bf16_t*)(R + R_U2); bf16_t* CQN = (bf16_t*)(dob + DO_CQN); bf16_t* CKVN = (bf16_t*)(dob + DO_CKVN);
            bf16_t* Qb = (bf16_t*)(R + R_Q); bf16_t* Kb = (bf16_t*)(R + R_K); bf16_t* VT = (bf16_t*)(R + R_VT); bf16_t* Ob = (bf16_t*)(R + R_O);
            bf16_t* Gb = (bf16_t*)(R + R_G);
            if (r < nmix) {
                if ((layer & 1) == 0) {
                    if (r == 0) { gk = 0; gA = HB; gB = ws + WS_EVIN + j * SZ_EVIN; gM = M; gN = 2560; gK = 1024; E.p0 = U1; E.i0 = 2048; E.p1 = GATE; E.i1 = 512; E.i2 = 2048; E.f2 = SS0; }
                    else if (r == 1) phase_evconv(U1, P->in[4] + j * 3 * 512, P->in[5] + j * 4 * 512, P->in[6] + j * 512, Y, XC);
                    else if (r == 2) { gk = 3; gA = XC; gB = ws + WS_EVG + j * SZ_EVG; gM = M; gN = 1024; gK = 128; gld = 512; gApn = 256; gBt = (size_t)512 * 512 + 256;
                                       E.p0 = A; E.p1 = XC; E.p2 = UU; E.f0 = P->in[8] + j * 512; E.f1 = P->in[10] + j * 512; E.f2 = P->in[11] + j * 512; }
                    else if (r == 3) phase_scan1(A, UU, agg);
                    else if (r == 4) phase_scan2(A, UU, agg, GATE, Y);
                    else if (r == 5) { gk = 2; gA = Y; gB = ws + WS_EVOUT + j * SZ_EVOUT; gM = M; gN = 1024; gK = 1024; E.i0 = 1024; E.p1 = HB; E.p2 = SS1; }
                    else { tf_ss = SS1; tf_n = 8; }
                } else {
                    if (r == 0) { gk = 0; gA = HB; gB = ws + WS_ODIN + j * SZ_ODIN; gM = M; gN = 768; gK = 1024; E.p0 = U2; E.i0 = 768; E.p1 = U2; E.i1 = 768; E.f2 = SS0; }
                    else if (r == 1) phase_oddnorm(U2, P->in[15] + j * 384, P->in[16] + j * 256, cs, sn, CQN, CKVN, Kb);
                    else if (r == 2) { gk = 4; gA = CQN; gB = ws + WS_UQ + j * SZ_UQ; gM = M; gN = 1536; gK = 384; E.p0 = Qb; E.f0 = cs; E.f1 = sn; E.scale = 0.14724444f; do_sync = false; }
                    else if (r == 3) { gk = 1; gA = CKVN; gB = ws + WS_UK + j * SZ_UK; gM = M; gN = 1024; gK = 256; E.p0 = Kb; E.i0 = 1536; do_sync = false; }
                    else if (r == 4) { gk = 6; gA = (const bf16_t*)(ws + WS_UV + j * SZ_UK); gB = CKVN; gM = 1024; gN = M; gK = 256; E.p0 = VT; E.i0 = 4160; }
                    else if (r == 5) {
#ifdef ATT_VAR
                        if (rep == 1) phase_attn<ATT_VAR>(lds, Qb, Kb, VT, (bf16_t*)dob); else
#endif
                        phase_attn<0>(lds, Qb, Kb, VT, Ob); }
                    else if (r == 6) { gk = 2; gA = Ob; gB = ws + WS_ODOUT + j * SZ_ODOUT; gM = M; gN = 1024; gK = 1024; E.i0 = 1024; E.p1 = HB; E.p2 = SS1; }
                    else { tf_ss = SS1; tf_n = 8; }
                }
            } else {
                r -= nmix;
                if (r == 0) { gk = 5; gA = HB - 2 * 1024; gB = ws + WS_UP + layer * SZ_UP; gM = 260 * 256; gN = 5632; gK = 1024; gAt = (size_t)254 * 1024 * 2;
                              E.p0 = Gb; E.f0 = P->in[22] + (size_t)layer * 3 * 5632; E.f1 = P->in[23] + (size_t)layer * 5632; E.i0 = M; E.halo = (LAS float*)(lds + 131072); E.f2 = SS1; }
                else if (r == 1) { gk = 2; gA = Gb; gB = ws + WS_DOWN + layer * SZ_DOWN; gM = M; gN = 1024; gK = 2816; E.i0 = 1024; E.p1 = HB; E.p2 = SS0; }
                else { tf_ss = SS0; tf_n = 22; }
            }
            if (tf_ss) phase_tailfin(HB, (const float*)(dob + DO_T), tf_n, tf_ss, (LAS float*)lds);
            if (gk >= 0) {
                E.kind = gk;
#ifdef PROBE_RESID
                if (gk == 2 && rep == 1 && probe_reps(ph) == 2) { E.p1 = dob; E.p2 = dob + 160 * MiB; }
#endif
#if ((PROBE_MASK >> 13) & 1) || defined(PROBE_NOEPI)
                if (rep == 1 && probe_reps(ph) == 2) { E.kind = 7; E.p0 = dob; }
#endif
                const int ld = gld ? gld : gK;
                const int npass = (gk == 2) ? 2 : 1;
                for (int pass = 0; pass < npass; ++pass) {
                    pg8::Gemm g{gA, (const bf16_t*)gB, gM, gN, gK, ld, ld, gAt ? gAt : (size_t)512 * ld, gBt ? gBt : (size_t)512 * ld, gApn, 0};
                    if (gk == 2) {
                        if (pass == 0) g.M = 65536;
                        else { g.A = gA + (size_t)65536 * ld; g.M = (gK / 128) * 256; g.K = 128; g.atstep = 256; g.b_pm = 256; E.kind = 8; E.p0 = dob + DO_T; }
                    }
                    pg8::StaticOrder S; S.init(g.M, g.N, (int)gridDim.x, (int)blockIdx.x); S.rev = (gk == 2 && gK == 2816 && pass == 0) ? 1 : 0;
                    pg8::gemm_phase<pg8::EpiAny, pg8::StaticOrder, true, PG8_SP2_FLAG>(lds, g, S, E);
                }
            }
        }
        }
#ifdef IDLE_PROBE
        if (ph == 5 || ph == 20) for (int i = 0; i < 128; ++i) __builtin_amdgcn_s_sleep(127);
#endif
        if (do_sync && ph + 1 < hi) { if (ph == lo) grid.sync(); else grid_bar(barw); }
    }
}

#ifndef MULTI_LAUNCH
#define MULTI_LAUNCH 0
#endif
extern "C" void kernel_launch(void* const* d_in, const int* in_sizes, int n_in, void* d_out, int out_size, void* d_ws, size_t ws_size, hipStream_t stream) {
    static int grid = 0;
    if (grid == 0) {
        if (n_in != 26 || ws_size < WS_NEED || out_size != NB * SEQ * DM) { fprintf(stderr, "kernel_launch: unexpected problem (n_in %d, ws %zu, out %d)\n", n_in, ws_size, out_size); grid = -1; return; }
        int dev = 0, cus = 0, per_cu = 0;
        hipGetDevice(&dev); hipDeviceGetAttribute(&cus, hipDeviceAttributeMultiprocessorCount, dev);
        if (hipFuncSetAttribute((const void*)mega, hipFuncAttributeMaxDynamicSharedMemorySize, LDS_BYTES) != hipSuccess) { fprintf(stderr, "kernel_launch: hipFuncSetAttribute failed\n"); grid = -1; return; }
        if (hipOccupancyMaxActiveBlocksPerMultiprocessor(&per_cu, (const void*)mega, 512, LDS_BYTES) != hipSuccess || per_cu < 1) { fprintf(stderr, "kernel_launch: occupancy query failed (%d)\n", per_cu); per_cu = 1; }
        (void)hipGetLastError();
        grid = 1; while (grid * 2 <= cus * per_cu) grid *= 2;
        fprintf(stderr, "kernel_launch: grid %d (cus %d x %d)\n", grid, cus, per_cu);
    }
    if (grid < 0) return;
    Params p{};
    for (int i = 0; i < 26; ++i) p.in[i] = (const float*)d_in[i];
    p.out = (float*)d_out; p.ws = (unsigned char*)d_ws;
#if MULTI_LAUNCH
    for (int i = 0; i < N_PHASES; ++i) { p.ph_lo = i; p.ph_hi = i + 1; hipLaunchKernelGGL(mega, dim3(grid), dim3(512), LDS_BYTES, stream, p); }
#else
    p.ph_lo = 0; p.ph_hi = N_PHASES;
    void* args[] = {&p};
    hipError_t e = hipLaunchCooperativeKernel((const void*)mega, dim3(grid), dim3(512), args, LDS_BYTES, stream);
    if (e != hipSuccess) fprintf(stderr, "cooperative launch failed: %s (grid %d)\n", hipGetErrorString(e), grid);
#endif
}
```
